# Optimizing an MI355X kernel written in HIP

```python
import math
import jax, jax.numpy as jnp
from jax import lax
import numpy as np

D_MODEL = 2048
BATCH = 2
SEQ = 4096
DEPTH = 4

N_MIXERS = 3
HEAD_DIM = 64
N_HEADS = D_MODEL // HEAD_DIM
N_KV = N_HEADS // 8
GQA_GROUP = N_HEADS // N_KV
Q_DIM = N_HEADS * HEAD_DIM
KV_DIM = N_KV * HEAD_DIM
ATTN_SCALE = HEAD_DIM ** -0.5
BLOCK = 128
SWA_WINDOW = 128
DIL_PATTERNS = ((128, 1), (512, 4), (2048, 16))
N_DIL = len(DIL_PATTERNS)
IDX_HEADS = 16
IDX_DIM = 64
TOPK_MAX = 256
D_FF = 256 * math.ceil(8 * D_MODEL / (3 * 256))
DEEPNORM_ALPHA = (2 * DEPTH) ** 0.25
DEEPNORM_BETA = (8 * DEPTH) ** -0.25
LN_EPS = 1e-5

A_IN = Q_DIM + 2 * KV_DIM
B_IN = N_DIL * (Q_DIM + 2 * KV_DIM)
C_SPLITS = (Q_DIM, Q_DIM + KV_DIM, Q_DIM + 2 * KV_DIM,
            Q_DIM + 2 * KV_DIM + IDX_HEADS * IDX_DIM,
            Q_DIM + 2 * KV_DIM + IDX_HEADS * IDX_DIM + IDX_DIM)
C_IN = C_SPLITS[-1] + IDX_HEADS

kernel_name = 'hybrid_swa_dilated_dsa_deepnorm'


def _n_layers_of(kind):
    return len(range(kind, DEPTH, N_MIXERS))


def alibi_slopes(n):
    return jnp.asarray(2.0 ** (-8.0 * np.arange(1, n + 1) / n), dtype=jnp.float32)


def layer_norm(x, g, b):
    xf = x.astype(jnp.float32)
    mu = xf.mean(-1, keepdims=True)
    var = jnp.square(xf - mu).mean(-1, keepdims=True)
    return ((xf - mu) * lax.rsqrt(var + LN_EPS) * g + b).astype(x.dtype)


def swiglu_ffn(x, w_gate_up, w_down):
    g, u = jnp.split(x @ w_gate_up, 2, axis=-1)
    return (jax.nn.silu(g) * u) @ w_down


def swa_sink_attention(x, w_in, sinks, w_out):
    B, S, _ = x.shape
    nb = S // BLOCK
    q, k, v = jnp.split(x @ w_in, [Q_DIM, Q_DIM + KV_DIM], axis=-1)
    q = q.reshape(B, nb, BLOCK, N_KV, GQA_GROUP, HEAD_DIM)
    k = k.reshape(B, nb, BLOCK, N_KV, HEAD_DIM)
    v = v.reshape(B, nb, BLOCK, N_KV, HEAD_DIM)

    def with_prev(t):
        prev = jnp.concatenate([jnp.zeros_like(t[:, :1]), t[:, :-1]], axis=1)
        return jnp.concatenate([prev, t], axis=2)

    kb, vb = with_prev(k), with_prev(v)
    s = jnp.einsum('bnqkgd,bnskd->bnkgqs', q, kb).astype(jnp.float32) * ATTN_SCALE
    qpos = jnp.arange(BLOCK)[:, None] + BLOCK
    kpos = jnp.arange(2 * BLOCK)[None, :]
    dist = qpos - kpos
    in_window = (dist >= 0) & (dist < SWA_WINDOW)
    has_prev = (jnp.arange(nb) > 0)[:, None, None] | (kpos >= BLOCK)[None]
    valid = in_window[None] & has_prev
    slopes = alibi_slopes(N_HEADS).reshape(N_KV, GQA_GROUP)[:, :, None, None]
    s = jnp.where(valid[None, :, None, None], s - slopes * dist, -jnp.inf)
    sink = sinks.astype(jnp.float32).reshape(N_KV, GQA_GROUP)[:, :, None, None]
    m = jnp.maximum(s.max(-1, keepdims=True), sink)
    p = jnp.exp(s - m)
    p = p / (p.sum(-1, keepdims=True) + jnp.exp(sink - m))
    o = jnp.einsum('bnkgqs,bnskd->bnqkgd', p.astype(vb.dtype), vb)
    return o.reshape(B, S, Q_DIM) @ w_out


def dilated_attention(x, w_in, w_out):
    B, S, _ = x.shape
    nb = S // BLOCK
    h = (x @ w_in).reshape(B, S, N_DIL, Q_DIM + 2 * KV_DIM)
    q = h[..., :Q_DIM].reshape(B, S, N_DIL, N_KV, GQA_GROUP, HEAD_DIM)
    k = h[..., Q_DIM:Q_DIM + KV_DIM].reshape(B, S, N_DIL, N_KV, HEAD_DIM)
    v = h[..., Q_DIM + KV_DIM:].reshape(B, S, N_DIL, N_KV, HEAD_DIM)
    k_groups = [k[:, :, g] for g in range(N_DIL)]
    v_groups = [v[:, :, g] for g in range(N_DIL)]
    slopes = alibi_slopes(N_HEADS).reshape(N_KV, GQA_GROUP)[:, :, None, None]

    def block(i):
        t = i * BLOCK + jnp.arange(BLOCK)
        qb = lax.dynamic_slice_in_dim(q, i * BLOCK, BLOCK, axis=1)
        outs, lses = [], []
        for g, (window, dilation) in enumerate(DIL_PATTERNS):
            dist = jnp.arange(window // dilation + 1) * dilation
            pos = t[:, None] - dist[None, :]
            valid = pos >= 0
            pos = jnp.maximum(pos, 0)
            kg = k_groups[g][:, pos]
            vg = v_groups[g][:, pos]
            s = jnp.einsum('bqkgd,bqjkd->bkgqj', qb[:, :, g], kg).astype(jnp.float32) * ATTN_SCALE
            s = jnp.where(valid, s - slopes * dist, -jnp.inf)
            lse = jax.nn.logsumexp(s, axis=-1)
            p = jnp.exp(s - lse[..., None])
            outs.append(jnp.einsum('bkgqj,bqjkd->bqkgd', p.astype(vg.dtype), vg))
            lses.append(lse.transpose(0, 3, 1, 2))
        wts = jax.nn.softmax(jnp.stack(lses), axis=0)
        o = jnp.sum(wts[..., None] * jnp.stack(outs).astype(jnp.float32), axis=0)
        return o.reshape(B, BLOCK, Q_DIM).astype(x.dtype)

    o = lax.map(block, jnp.arange(nb))
    o = jnp.moveaxis(o, 0, 1).reshape(B, S, Q_DIM)
    return o @ w_out


def dsa_sparse_attention(x, w_in, w_out):
    B, S, _ = x.shape
    nb = S // BLOCK
    top_k = min(TOPK_MAX, S // 4)
    q, k, v, qi, ki, wi = jnp.split(x @ w_in, list(C_SPLITS), axis=-1)
    q = q.reshape(B, S, N_KV, GQA_GROUP, HEAD_DIM)
    k = k.reshape(B, S, N_KV, HEAD_DIM)
    v = v.reshape(B, S, N_KV, HEAD_DIM)
    qi = qi.reshape(B, S, IDX_HEADS, IDX_DIM)
    wi = wi.astype(jnp.float32) * IDX_HEADS ** -0.5
    kpos = jnp.arange(S)
    slopes = alibi_slopes(N_HEADS).reshape(N_KV, GQA_GROUP)[None, :, :, None, None]
    gather = jax.vmap(lambda tab, idx: tab[idx])

    def block(i):
        t = i * BLOCK + jnp.arange(BLOCK)
        qib = lax.dynamic_slice_in_dim(qi, i * BLOCK, BLOCK, axis=1)
        wib = lax.dynamic_slice_in_dim(wi, i * BLOCK, BLOCK, axis=1)
        rel = jax.nn.relu(jnp.einsum('bqhd,bsd->bqhs', qib, ki).astype(jnp.float32) * IDX_DIM ** -0.5)
        score = jnp.einsum('bqhs,bqh->bqs', rel, wib)
        score = jnp.where(kpos[None, None, :] <= t[None, :, None], score, -jnp.inf)
        _, idx = lax.top_k(score, top_k)
        valid = idx <= t[None, :, None]
        kg = gather(k, idx)
        vg = gather(v, idx)
        qb = lax.dynamic_slice_in_dim(q, i * BLOCK, BLOCK, axis=1)
        s = jnp.einsum('bqkgd,bqjkd->bkgqj', qb, kg).astype(jnp.float32) * ATTN_SCALE
        dist = (t[None, :, None] - idx)[:, None, None]
        s = jnp.where(valid[:, None, None], s - slopes * dist, -jnp.inf)
        p = jax.nn.softmax(s, axis=-1)
        o = jnp.einsum('bkgqj,bqjkd->bqkgd', p.astype(vg.dtype), vg)
        return o.reshape(B, BLOCK, Q_DIM)

    o = lax.map(block, jnp.arange(nb))
    o = jnp.moveaxis(o, 0, 1).reshape(B, S, Q_DIM)
    return o @ w_out


def setup_inputs(seed: int = 0) -> dict:
    key = jax.random.key(seed)
    ks = jax.random.split(key, 12)
    n_a, n_b, n_c = (_n_layers_of(m) for m in range(N_MIXERS))

    def nrm(k, shape, scale):
        return jax.random.normal(k, shape, jnp.float32) * scale

    out_scale = Q_DIM ** -0.5 * DEEPNORM_BETA
    return {
        'x': nrm(ks[0], (BATCH, SEQ, D_MODEL), 1.0),
        'a_w_in': nrm(ks[1], (n_a, D_MODEL, A_IN), D_MODEL ** -0.5),
        'a_sinks': nrm(ks[2], (n_a, N_HEADS), 0.5),
        'a_w_out': nrm(ks[3], (n_a, Q_DIM, D_MODEL), out_scale),
        'b_w_in': nrm(ks[4], (n_b, D_MODEL, B_IN), D_MODEL ** -0.5),
        'b_w_out': nrm(ks[5], (n_b, Q_DIM, D_MODEL), out_scale),
        'c_w_in': nrm(ks[6], (n_c, D_MODEL, C_IN), D_MODEL ** -0.5),
        'c_w_out': nrm(ks[7], (n_c, Q_DIM, D_MODEL), out_scale),
        'ln_g': 1.0 + nrm(ks[8], (DEPTH, 2, D_MODEL), 0.02),
        'ln_b': nrm(ks[9], (DEPTH, 2, D_MODEL), 0.02),
        'ffn_w_gate_up': nrm(ks[10], (DEPTH, D_MODEL, 2 * D_FF), D_MODEL ** -0.5),
        'ffn_w_down': nrm(ks[11], (DEPTH, D_FF, D_MODEL), D_FF ** -0.5 * DEEPNORM_BETA),
    }


def reference(x, a_w_in, a_sinks, a_w_out, b_w_in, b_w_out, c_w_in, c_w_out, ln_g, ln_b, ffn_w_gate_up, ffn_w_down):
    for i in range(DEPTH):
        kind, j = i % N_MIXERS, i // N_MIXERS
        if kind == 0:
            y = swa_sink_attention(x, a_w_in[j], a_sinks[j], a_w_out[j])
        elif kind == 1:
            y = dilated_attention(x, b_w_in[j], b_w_out[j])
        else:
            y = dsa_sparse_attention(x, c_w_in[j], c_w_out[j])
        x = layer_norm(DEEPNORM_ALPHA * x + y, ln_g[i, 0], ln_b[i, 0])
        x = layer_norm(DEEPNORM_ALPHA * x + swiglu_ffn(x, ffn_w_gate_up[i], ffn_w_down[i]), ln_g[i, 1], ln_b[i, 1])
    return x
```

```cpp
#include <hip/hip_runtime.h>
#include <cstdio>
#include <cstdint>
namespace pg8 {
#define PG8_LAS __attribute__((address_space(3)))
typedef unsigned short bf16_t;
typedef short bf16x8 __attribute__((ext_vector_type(8)));
typedef float f32x4 __attribute__((ext_vector_type(4)));
typedef unsigned u32x4 __attribute__((ext_vector_type(4)));
constexpr int BM = 256, BK = 64, HALF = 128, HTB = HALF * BK * 2  , STAGE_BYTES = 8 * HTB, NXCD = 8, WGM = 8;

__host__ __device__ __forceinline__ int lds_byte(int r, int c) { const int st = (r >> 4) * 2 + (c >> 5), rr = r & 15, cc = c & 31, ob = rr * 64 + cc * 2; return st * 1024 + (ob ^ (((ob >> 9) & 1) << 5)); }
__host__ __device__ __forceinline__ void stage_rc(int b, int& R, int& C) { const int st = b / 1024, sb = b % 1024, swz = sb ^ (((sb >> 9) & 1) << 5); R = (st >> 1) * 16 + swz / 64; C = (st & 1) * 32 + (swz % 64) / 2; }
__host__ __device__ __forceinline__ int perm32(int rho) { const int n = rho >> 4, i = rho & 15; return 8 * (i >> 2) + 4 * n + (i & 3); }

struct Unit { int pm, pn; };
struct Gemm { const bf16_t* A; const bf16_t* Bt; int M, N, K; };

struct StaticOrder {
    int nM, nN, nwg, G, c;
    __host__ __device__ void init(int M, int N, int G_, int c_) { nM = M / BM; nN = N / BM; nwg = nM * nN; G = G_; c = c_; }
    __host__ __device__ bool next(int i, Unit& u) const {
        const long L = (long)i * G + c; if (L >= nwg) return false;
        int wgid = (int)L; { const int q = nwg / NXCD, r = nwg % NXCD, xcd = wgid % NXCD, off = wgid / NXCD; wgid = (xcd < r ? xcd * (q + 1) : r * (q + 1) + (xcd - r) * q) + off; }
        const int nig = WGM * nN, gid = wgid / nig, fm = gid * WGM, gsz = (nM - fm) < WGM ? (nM - fm) : WGM;
        u.pm = fm + ((wgid % nig) % gsz); u.pn = (wgid % nig) / gsz; return true;
    }
    __device__ __forceinline__ void a_ready(const Unit&) const {}
    __device__ __forceinline__ void done(const Unit&) const {}
};


__device__ __forceinline__ unsigned cvt_pk_bf16(float lo, float hi) { unsigned r; asm volatile("v_cvt_pk_bf16_f32 %0, %1, %2" : "=v"(r) : "v"(lo), "v"(hi)); return r; }

struct EpiQKV {
    static constexpr bool PERM = true, AFTER_DRAIN = false;
    bf16_t* O; int ldc; int qmod, qlim; float qscale;
    __device__ __forceinline__ void operator()(const f32x4 (&acc)[2][2][4][2], const Unit& u, int wr, int wc, int fr, int fq) const {
        const int row0 = u.pm * BM + wr * 64 + fr; const int colt = u.pn * BM;
        const float sc = ((colt % qmod) < qlim) ? qscale : 1.f;
        const int col0 = colt + wc * 32 + 8 * fq;
#pragma unroll
        for (int ai = 0; ai < 2; ++ai)
#pragma unroll
            for (int m = 0; m < 4; ++m) { bf16_t* rowp = O + (size_t)(row0 + ai * HALF + m * 16) * ldc + col0;
#pragma unroll
                for (int bj = 0; bj < 2; ++bj) { f32x4 v0 = acc[ai][bj][m][0] * sc, v1 = acc[ai][bj][m][1] * sc;
                    u32x4 w; w.x = cvt_pk_bf16(v0[0], v0[1]); w.y = cvt_pk_bf16(v0[2], v0[3]); w.z = cvt_pk_bf16(v1[0], v1[1]); w.w = cvt_pk_bf16(v1[2], v1[3]);
                    *(u32x4*)(rowp + bj * HALF) = w; } }
    }
};
struct EpiSwiGLU {
    static constexpr bool PERM = true, AFTER_DRAIN = false;
    bf16_t* Hh; int ldc;
    __device__ __forceinline__ float sg(float g, float uu) const { const float e = __builtin_amdgcn_exp2f(g * -1.4426950408889634f); return g * __builtin_amdgcn_rcpf(1.0f + e) * uu; }
    __device__ __forceinline__ void operator()(const f32x4 (&acc)[2][2][4][2], const Unit& u, int wr, int wc, int fr, int fq) const {
        const int row0 = u.pm * BM + wr * 64 + fr; const int col0 = u.pn * HALF + wc * 32 + 8 * fq;
#pragma unroll
        for (int ai = 0; ai < 2; ++ai)
#pragma unroll
            for (int m = 0; m < 4; ++m) { bf16_t* rowp = Hh + (size_t)(row0 + ai * HALF + m * 16) * ldc + col0;
                const f32x4 g0 = acc[ai][0][m][0], g1 = acc[ai][0][m][1], u0 = acc[ai][1][m][0], u1 = acc[ai][1][m][1];
                u32x4 w; w.x = cvt_pk_bf16(sg(g0[0], u0[0]), sg(g0[1], u0[1])); w.y = cvt_pk_bf16(sg(g0[2], u0[2]), sg(g0[3], u0[3]));
                w.z = cvt_pk_bf16(sg(g1[0], u1[0]), sg(g1[1], u1[1])); w.w = cvt_pk_bf16(sg(g1[2], u1[2]), sg(g1[3], u1[3]));
                *(u32x4*)rowp = w; }
    }
};
struct EpiResid {
    static constexpr bool PERM = false, AFTER_DRAIN = false;
    const float* base; float* out; int ldc; float alpha;
    __device__ __forceinline__ void operator()(const f32x4 (&acc)[2][2][4][2], const Unit& u, int wr, int wc, int fr, int fq) const {
        const int row0 = u.pm * BM + wr * 64 + fr, col0 = u.pn * BM + wc * 32 + 4 * fq;
#pragma unroll
        for (int ai = 0; ai < 2; ++ai)
#pragma unroll
            for (int m = 0; m < 4; ++m) { const size_t off = (size_t)(row0 + ai * HALF + m * 16) * ldc + col0;
#pragma unroll
                for (int bj = 0; bj < 2; ++bj)
#pragma unroll
                    for (int n = 0; n < 2; ++n) { const f32x4 bs = *(const f32x4*)(base + off + bj * HALF + n * 16); *(f32x4*)(out + off + bj * HALF + n * 16) = bs * alpha + acc[ai][bj][m][n]; }
                asm volatile("" ::: "memory"); }
    }
};

template <class Epi, class Sched, bool ALIGN_EPI = false, bool SP2 = false>
__device__ __forceinline__ void gemm_phase(PG8_LAS unsigned char* lds, const Gemm g, const Sched& S, const Epi& E) {
    int tid_ = threadIdx.x; asm volatile("" : "+v"(tid_));
    const int tid = tid_, wid = __builtin_amdgcn_readfirstlane(tid >> 6), lane = tid & 63, wr = wid >> 2, wc = wid & 3, fr = lane & 15, fq = lane >> 4;
    const int K = g.K, nt = K / BK;
    unsigned voffA[2], voffB[2];
#pragma unroll
    for (int i = 0; i < 2; ++i) { int R, C; stage_rc(tid * 16 + i * 8192, R, C); const int Rb = Epi::PERM ? ((R & ~31) + perm32(R & 31)) : R;
        voffA[i] = (unsigned)(R * K + C) * 2u; voffB[i] = (unsigned)(Rb * K + C) * 2u; }
    const size_t kstep = (size_t)(BK * 2);
    const size_t hstep = (size_t)HALF * K * 2;
    const size_t tstep = 2 * hstep;
    const unsigned ldsw = (unsigned)wid * 1024u;
    const int aoff = lds_byte(wr * 64 + fr, fq * 8), boff = lds_byte(wc * 32 + fr, fq * 8);
#define PG8_SA(b, h) (((b) * 2 + (h)) * HTB)
#define PG8_SB(b, h) ((4 + (b) * 2 + (h)) * HTB)
#define PG8_STAGE(bufoff, gbase, voff) do { _Pragma("unroll") for (int _i = 0; _i < 2; ++_i) \
        __builtin_amdgcn_global_load_lds((const unsigned*)((const char*)(gbase) + (voff)[_i]), (PG8_LAS unsigned*)(lds + (bufoff) + ldsw + _i * 8192), 16, 0, 0); } while (0)
#define PG8_LDA(dst, b, h) do { _Pragma("unroll") for (int m = 0; m < 4; ++m) _Pragma("unroll") for (int k = 0; k < 2; ++k) dst[m][k] = *(const PG8_LAS bf16x8*)(lds + PG8_SA(b, h) + aoff + m * 2048 + k * 1024); } while (0)
#define PG8_LDB(dst, b, h) do { _Pragma("unroll") for (int n = 0; n < 2; ++n) _Pragma("unroll") for (int k = 0; k < 2; ++k) dst[n][k] = *(const PG8_LAS bf16x8*)(lds + PG8_SB(b, h) + boff + n * 2048 + k * 1024); } while (0)
#define PG8_MMA(ai, bj, At, Bt) do { __builtin_amdgcn_s_setprio(1); _Pragma("unroll") for (int m = 0; m < 4; ++m) _Pragma("unroll") for (int n = 0; n < 2; ++n) _Pragma("unroll") for (int k = 0; k < 2; ++k) \
        acc[ai][bj][m][n] = __builtin_amdgcn_mfma_f32_16x16x32_bf16(Bt[n][k], At[m][k], acc[ai][bj][m][n], 0, 0, 0); __builtin_amdgcn_s_setprio(0); } while (0)
#define PG8_WAIT_V(n) asm volatile("s_waitcnt vmcnt(" #n ")" ::: "memory")
#define PG8_WAIT_L(n) asm volatile("s_waitcnt lgkmcnt(" #n ")" ::: "memory")
#define PG8_BAR __builtin_amdgcn_s_barrier()
#define PG8_SCHED __builtin_amdgcn_sched_barrier(0)
    Unit cur, nxt; int ui = 0;
    if (!S.next(0, cur)) return;
    f32x4 acc[2][2][4][2];
#pragma unroll
    for (int a = 0; a < 2; ++a)
#pragma unroll
        for (int b = 0; b < 2; ++b)
#pragma unroll
            for (int m = 0; m < 4; ++m)
#pragma unroll
                for (int n = 0; n < 2; ++n) acc[a][b][m][n] = (f32x4){0.f, 0.f, 0.f, 0.f};
    bf16x8 At[4][2], B0[2][2], B1[2][2];
    const char* cA = (const char*)g.A + (size_t)cur.pm * tstep; const char* cB = (const char*)g.Bt + (size_t)cur.pn * tstep;
    S.a_ready(cur);
    if constexpr (SP2) {
        PG8_STAGE(PG8_SB(0, 0), cB, voffB); PG8_STAGE(PG8_SB(0, 1), cB + hstep, voffB); PG8_STAGE(PG8_SA(0, 0), cA, voffA); PG8_STAGE(PG8_SA(0, 1), cA + hstep, voffA);
        if (wr == 1) PG8_BAR;
        PG8_WAIT_V(2); PG8_BAR;
        PG8_STAGE(PG8_SB(1, 0), cB + kstep, voffB); PG8_STAGE(PG8_SA(1, 0), cA + kstep, voffA); PG8_STAGE(PG8_SB(1, 1), cB + hstep + kstep, voffB);
        PG8_WAIT_V(6); PG8_BAR;
    } else {
        PG8_STAGE(PG8_SB(0, 0), cB, voffB); PG8_STAGE(PG8_SA(0, 0), cA, voffA); PG8_STAGE(PG8_SB(0, 1), cB + hstep, voffB); PG8_STAGE(PG8_SA(0, 1), cA + hstep, voffA);
        if (wr == 1) PG8_BAR;
        PG8_WAIT_V(4); PG8_BAR;
        PG8_STAGE(PG8_SB(1, 0), cB + kstep, voffB); PG8_STAGE(PG8_SA(1, 0), cA + kstep, voffA); PG8_STAGE(PG8_SB(1, 1), cB + hstep + kstep, voffB);
        PG8_WAIT_V(6); PG8_BAR;
    }
    for (;;) {
        const bool has_next = S.next(ui + 1, nxt);
        const char* nA = has_next ? (const char*)g.A + (size_t)nxt.pm * tstep : cA; const char* nB = has_next ? (const char*)g.Bt + (size_t)nxt.pn * tstep : cB;
        for (int t = 0; t < nt; t += 2) {
            const bool last = (t == nt - 2);
            const char* a1 = cA + (size_t)(t + 1) * kstep;
            const char* a2 = last ? nA : cA + (size_t)(t + 2) * kstep; const char* b2 = last ? nB : cB + (size_t)(t + 2) * kstep;
            const char* a3 = a2 + kstep; const char* b3 = b2 + kstep;
            if (last && has_next) S.a_ready(nxt);
            if constexpr (SP2) {
            PG8_LDB(B0, 0, 0); PG8_LDB(B1, 0, 1); PG8_SCHED; PG8_LDA(At, 0, 0); PG8_STAGE(PG8_SA(1, 1), a1 + hstep, voffA);
            PG8_WAIT_V(8); PG8_WAIT_L(0); PG8_BAR; PG8_MMA(0, 0, At, B0); PG8_MMA(0, 1, At, B1); PG8_BAR; PG8_SCHED;
            PG8_LDA(At, 0, 1); PG8_STAGE(PG8_SB(0, 0), b2, voffB); PG8_STAGE(PG8_SB(0, 1), b2 + hstep, voffB); PG8_STAGE(PG8_SA(0, 0), a2, voffA);
            PG8_WAIT_V(8); PG8_WAIT_L(0); PG8_BAR; PG8_MMA(1, 0, At, B0); PG8_MMA(1, 1, At, B1); PG8_BAR; PG8_SCHED;
            PG8_LDB(B0, 1, 0); PG8_LDB(B1, 1, 1); PG8_SCHED; PG8_LDA(At, 1, 0); PG8_STAGE(PG8_SA(0, 1), a2 + hstep, voffA);
            PG8_WAIT_V(8); PG8_WAIT_L(0); PG8_BAR; PG8_MMA(0, 0, At, B0); PG8_MMA(0, 1, At, B1); PG8_BAR; PG8_SCHED;
            PG8_LDA(At, 1, 1); PG8_STAGE(PG8_SB(1, 0), b3, voffB); PG8_STAGE(PG8_SB(1, 1), b3 + hstep, voffB); PG8_STAGE(PG8_SA(1, 0), a3, voffA);
            PG8_WAIT_V(8); PG8_WAIT_L(0); PG8_BAR; PG8_MMA(1, 0, At, B0); PG8_MMA(1, 1, At, B1); PG8_BAR; PG8_SCHED;
            } else {
            PG8_LDB(B0, 0, 0); PG8_SCHED; PG8_LDA(At, 0, 0); PG8_STAGE(PG8_SA(1, 1), a1 + hstep, voffA);
            PG8_WAIT_L(8); PG8_BAR; PG8_WAIT_L(0); PG8_MMA(0, 0, At, B0); PG8_BAR; PG8_SCHED;
            PG8_LDB(B1, 0, 1); PG8_STAGE(PG8_SB(0, 0), b2, voffB);
            PG8_BAR; PG8_WAIT_L(0); PG8_MMA(0, 1, At, B1); PG8_BAR;
            PG8_LDA(At, 0, 1); PG8_STAGE(PG8_SA(0, 0), a2, voffA);
            PG8_BAR; PG8_WAIT_L(0); PG8_MMA(1, 0, At, B0); PG8_BAR; PG8_SCHED;
            PG8_STAGE(PG8_SB(0, 1), b2 + hstep, voffB);
            PG8_WAIT_V(6); PG8_BAR; PG8_MMA(1, 1, At, B1); PG8_BAR;
            PG8_LDB(B0, 1, 0); PG8_SCHED; PG8_LDA(At, 1, 0); PG8_STAGE(PG8_SA(0, 1), a2 + hstep, voffA);
            PG8_WAIT_L(8); PG8_BAR; PG8_WAIT_L(0); PG8_MMA(0, 0, At, B0); PG8_BAR; PG8_SCHED;
            PG8_LDB(B1, 1, 1); PG8_STAGE(PG8_SB(1, 0), b3, voffB);
            PG8_BAR; PG8_WAIT_L(0); PG8_MMA(0, 1, At, B1); PG8_BAR;
            PG8_LDA(At, 1, 1); PG8_STAGE(PG8_SA(1, 0), a3, voffA);
            PG8_BAR; PG8_WAIT_L(0); PG8_MMA(1, 0, At, B0); PG8_BAR; PG8_SCHED;
            PG8_STAGE(PG8_SB(1, 1), b3 + hstep, voffB);
            PG8_WAIT_V(6); PG8_BAR; PG8_MMA(1, 1, At, B1); PG8_BAR;
            }
        }
        if constexpr (ALIGN_EPI) { if (wr == 0) PG8_BAR; }
        if constexpr (!Epi::AFTER_DRAIN) { E(acc, cur, wr, wc, fr, fq); S.done(cur); }
        if (!has_next) break;
#pragma unroll
        for (int a = 0; a < 2; ++a)
#pragma unroll
            for (int b = 0; b < 2; ++b)
#pragma unroll
                for (int m = 0; m < 4; ++m)
#pragma unroll
                    for (int n = 0; n < 2; ++n) acc[a][b][m][n] = (f32x4){0.f, 0.f, 0.f, 0.f};
        cur = nxt; cA = nA; cB = nB; ++ui;
        if constexpr (ALIGN_EPI) { if (wr == 1) PG8_BAR; }
    }
    PG8_WAIT_V(0);
    if constexpr (!ALIGN_EPI) { if (wr == 0) PG8_BAR; }
    PG8_BAR;
    if constexpr (Epi::AFTER_DRAIN) { E.fused(acc, cur, wr, wc, fr, fq, lds, wid, lane); S.done(cur); }
#undef PG8_SA
#undef PG8_SB
#undef PG8_STAGE
#undef PG8_LDA
#undef PG8_LDB
#undef PG8_MMA
#undef PG8_WAIT_V
#undef PG8_WAIT_L
#undef PG8_BAR
#undef PG8_SCHED
}
}
#define GAS __attribute__((address_space(1)))
#define LAS __attribute__((address_space(3)))
typedef unsigned short bf16;
typedef unsigned v4u __attribute__((ext_vector_type(4)));
typedef float f32x4 __attribute__((ext_vector_type(4)));
typedef short bf16x8 __attribute__((ext_vector_type(8)));
typedef GAS unsigned gu32;
typedef GAS unsigned long long gu64;
#define RLX_AGENT __ATOMIC_RELAXED, __HIP_MEMORY_SCOPE_AGENT
#define LDS_WAIT() asm volatile("s_waitcnt lgkmcnt(0)" ::: "memory")
#define VM_WAIT() asm volatile("s_waitcnt vmcnt(0)" ::: "memory")
__device__ __forceinline__ unsigned long long rt() { return __builtin_amdgcn_s_memrealtime(); }
__device__ __forceinline__ unsigned f2bf(float f) { unsigned u = __builtin_bit_cast(unsigned, f); return (u + 0x7fffu + ((u >> 16) & 1u)) >> 16; }
__device__ __forceinline__ unsigned pk2(float lo, float hi) { return f2bf(lo) | (f2bf(hi) << 16); }

#define XB_TMO      128
#define XB_XCNT(j)  (256  + 64 * (j))
#define XB_XSUB(j)  (1280 + 64 * (j))
#define XB_XGEN(j)  (2304 + 64 * (j))
#define XB_TOP      3328
#define XB_TOPGEN   3392
#define XCD_BAR_WORDS 3456
#define XB_SPIN_CAP (1u << 18)

__device__ __forceinline__ unsigned xb_ld(unsigned* p)              { return __hip_atomic_load(p, __ATOMIC_RELAXED, __HIP_MEMORY_SCOPE_AGENT); }
__device__ __forceinline__ unsigned xb_add(unsigned* p, unsigned v) { return __hip_atomic_fetch_add(p, v, __ATOMIC_RELAXED, __HIP_MEMORY_SCOPE_AGENT); }
__device__ __forceinline__ unsigned xb_xcc_id() { return (unsigned)__builtin_amdgcn_s_getreg((3 << 11) | 20) & 0xFu; }
#define XB_SPIN(cond, bar) do { unsigned _sp = 0; while (cond) { __builtin_amdgcn_s_sleep(1); \
    if ((++_sp & 255u) == 0u) { if (xb_ld(&(bar)[XB_TMO])) break; if (_sp > XB_SPIN_CAP) { atomicAdd(&(bar)[XB_TMO], 1u); break; } } } } while (0)

struct XcdBarrier {
    unsigned* bar; unsigned x;
    volatile LAS unsigned* st;
};

__device__ __forceinline__ XcdBarrier xcd_barrier_post(unsigned* bar, volatile LAS unsigned* st) {
    XcdBarrier b; b.bar = bar; b.x = xb_xcc_id(); b.st = st;
    if (threadIdx.x == 0) (void)xb_add(&bar[XB_XCNT(b.x)], 1u);
    return b;
}
__device__ __forceinline__ void xcd_barrier_complete(unsigned* bar, unsigned x, unsigned& nloc, unsigned& nx) {
    const unsigned G = gridDim.x * gridDim.y * gridDim.z;
    unsigned sum, cnt, mine, sp = 0u;
    for (;;) {
        sum = 0u; cnt = 0u; mine = 0u;
#pragma unroll
        for (unsigned j = 0; j < 16; ++j) { const unsigned c = xb_ld(&bar[XB_XCNT(j)]); sum += c; cnt += (c > 0u) ? 1u : 0u; mine = (j == x) ? c : mine; }
        if (sum == G) break;
        __builtin_amdgcn_s_sleep(1);
        if ((++sp & 255u) == 0u) { if (xb_ld(&bar[XB_TMO])) break; if (sp > XB_SPIN_CAP) { atomicAdd(&bar[XB_TMO], 1u); break; } }
    }
    nloc = mine > 0u ? mine : 1u; nx = cnt > 0u ? cnt : 1u;
}

__device__ __forceinline__ void xcd_barrier(const XcdBarrier& b) {
    asm volatile("s_waitcnt vmcnt(0)" ::: "memory");
    __syncthreads();
    if (threadIdx.x == 0) {
        unsigned* bar = b.bar;
        __builtin_amdgcn_s_waitcnt(0);
        unsigned nloc = b.st[0], nx = b.st[1];
        if (nloc == 0u) { xcd_barrier_complete(bar, b.x, nloc, nx); b.st[0] = nloc; b.st[1] = nx; }
        const unsigned old = xb_add(&bar[XB_XSUB(b.x)], 1u);
        const unsigned gen = old / nloc;
        if (old + 1u == (gen + 1u) * nloc) {
            __builtin_amdgcn_fence(__ATOMIC_RELEASE, "agent");
            asm volatile("s_waitcnt vmcnt(0)" ::: "memory");
            const unsigned og = xb_add(&bar[XB_TOP], 1u);
            const unsigned tg = og / nx;
            if (og + 1u == (tg + 1u) * nx) xb_add(&bar[XB_TOPGEN], 1u);
            else XB_SPIN(xb_ld(&bar[XB_TOPGEN]) == tg, bar);
            __builtin_amdgcn_fence(__ATOMIC_ACQUIRE, "agent");
            xb_add(&bar[XB_XGEN(b.x)], 1u);
            asm volatile("s_waitcnt vmcnt(0)" ::: "memory");
        } else {
            XB_SPIN(xb_ld(&bar[XB_XGEN(b.x)]) == gen, bar);
            __builtin_amdgcn_fence(__ATOMIC_ACQUIRE, "agent");
            asm volatile("s_waitcnt vmcnt(0)" ::: "memory");
        }
    }
    __syncthreads();
}

constexpr int BATCH = 2, SEQ = 4096, DM = 2048, MTOK = BATCH * SEQ, DEPTH = 4;
constexpr int NH = 32, NKV = 4, HD = 64, QD = 2048, KVD = 256;
constexpr int A_IN = 2560, B_IN = 7680, C_IN = 3664, C_INP = 3840;
constexpr int DFF = 5632, NGU = 2 * DFF;
constexpr int IDXH = 16, IDXD = 64, TOPK = 256;
constexpr int C_QI = 2560, C_KI = 3584, C_WI = 3648;
constexpr float ALPHA = 1.6817928305074290f;
constexpr float LN_EPS = 1e-5f;
constexpr float LOG2E = 1.4426950408889634f;
constexpr float C2 = 0.125f * LOG2E;

constexpr size_t MiB = 1u << 20;
constexpr size_t WS_CTL = 0, CTL_ZERO_BYTES = 1 * MiB;
constexpr size_t WS_W_AIN = 2 * MiB;
constexpr size_t WS_W_AOUT = WS_W_AIN + 20 * MiB;
constexpr size_t WS_W_BIN = WS_W_AOUT + 16 * MiB;
constexpr size_t WS_W_BOUT = WS_W_BIN + 30 * MiB;
constexpr size_t WS_W_CIN = WS_W_BOUT + 8 * MiB;
constexpr size_t WS_W_COUT = WS_W_CIN + 15 * MiB;
constexpr size_t WS_W_GU = WS_W_COUT + 8 * MiB;
constexpr size_t WS_W_DN = WS_W_GU + 176 * MiB;
constexpr size_t WS_X = WS_W_DN + 88 * MiB;
constexpr size_t WS_XB = WS_X + 64 * MiB;
constexpr size_t WS_Z = WS_XB + 32 * MiB;
constexpr size_t WS_O = WS_Z + 64 * MiB;
constexpr size_t WS_MASK = WS_O + 32 * MiB;
constexpr size_t WS_QKV = WS_MASK + 4 * MiB;
constexpr size_t WS_H = WS_QKV + 120 * MiB;
constexpr size_t WS_SC = WS_H;
constexpr size_t WS_END = WS_H + 128 * MiB;
constexpr int CW_BAR = 4096;

constexpr int RING_BYTES = 131072;
constexpr int LDSCTL_OFF = RING_BYTES, MISC_OFF = LDSCTL_OFF + 320;
constexpr int LDS_BYTES = 147456;
constexpr int NWAVES = 8;

typedef unsigned long long u64;
#define OPAQUE_V(x) asm volatile("" : "+v"(x))
#define OPAQUE_S(x) asm volatile("" : "+s"(x))

__device__ __forceinline__ float bf_lo(unsigned u) { return __uint_as_float(u << 16); }
__device__ __forceinline__ float bf_hi(unsigned u) { return __uint_as_float(u & 0xffff0000u); }
__device__ __forceinline__ float wave_sum(float v) {
#pragma unroll
    for (int o = 1; o < 64; o <<= 1) v += __shfl_xor(v, o);
    return v;
}
__device__ __forceinline__ unsigned wave_sum_u(unsigned v) {
#pragma unroll
    for (int o = 1; o < 64; o <<= 1) v += (unsigned)__shfl_xor((int)v, o);
    return v;
}

__device__ __forceinline__ void conv_item(const float* W, int K, int N, int Npad, bf16* WT, int mode, LAS float* scr, int item, int lane) {
    const int nblk = Npad / 32, kb = item / nblk, nb = item % nblk, k0 = 64 * kb, n0 = 32 * nb;
    const int ncol = n0 + (lane & 31); const bool nok = ncol < N;
#pragma unroll 8
    for (int i = 0; i < 32; ++i) { const int kk = 2 * i + (lane >> 5); scr[kk * 33 + (lane & 31)] = nok ? W[(size_t)(k0 + kk) * N + ncol] : 0.f; }
    LDS_WAIT(); asm volatile("" ::: "memory");
    int row0 = n0;
    if (mode == 1) { if (n0 < DFF) row0 = 256 * (n0 / 128) + (n0 % 128); else { const int c = n0 - DFF; row0 = 256 * (c / 128) + 128 + (c % 128); } }
    const int c = lane & 7;
#pragma unroll
    for (int j = 0; j < 4; ++j) { const int n = (lane >> 3) + 8 * j; const LAS float* s = scr + (8 * c) * 33 + n;
        v4u o; o.x = pk2(s[0 * 33], s[1 * 33]); o.y = pk2(s[2 * 33], s[3 * 33]); o.z = pk2(s[4 * 33], s[5 * 33]); o.w = pk2(s[6 * 33], s[7 * 33]);
        *(GAS v4u*)(WT + (size_t)(row0 + n) * K + k0 + 8 * c) = o; }
    LDS_WAIT(); asm volatile("" ::: "memory");
}

struct Params {
    const float* x; const float* a_w_in; const float* a_sinks; const float* a_w_out; const float* b_w_in; const float* b_w_out;
    const float* c_w_in; const float* c_w_out; const float* ln_g; const float* ln_b; const float* w_gu; const float* w_dn;
    float* out; unsigned char* ws;
    int ph_lo, ph_hi, li, pad;
};

__device__ __forceinline__ void prologue_phase(const Params& p, LAS unsigned char* lds, int gw, int NGW, int wave, int lane) {
    OPAQUE_V(lane); OPAQUE_S(gw); OPAQUE_S(wave);
    LAS float* scr = (LAS float*)(lds + wave * 16384);
    unsigned char* ws = p.ws;
    for (int mi = 0; mi < 16; ++mi) {
        const float* W; bf16* WT; int K, N, Npad, mode = 0;
        if (mi < 2)       { W = p.a_w_in + (size_t)mi * DM * A_IN;  WT = (bf16*)(ws + WS_W_AIN) + (size_t)mi * A_IN * DM;  K = DM; N = A_IN; Npad = A_IN; }
        else if (mi < 4)  { W = p.a_w_out + (size_t)(mi - 2) * QD * DM; WT = (bf16*)(ws + WS_W_AOUT) + (size_t)(mi - 2) * DM * QD; K = QD; N = DM; Npad = DM; }
        else if (mi == 4) { W = p.b_w_in;  WT = (bf16*)(ws + WS_W_BIN);  K = DM; N = B_IN; Npad = B_IN; }
        else if (mi == 5) { W = p.b_w_out; WT = (bf16*)(ws + WS_W_BOUT); K = QD; N = DM; Npad = DM; }
        else if (mi == 6) { W = p.c_w_in;  WT = (bf16*)(ws + WS_W_CIN);  K = DM; N = C_IN; Npad = C_INP; }
        else if (mi == 7) { W = p.c_w_out; WT = (bf16*)(ws + WS_W_COUT); K = QD; N = DM; Npad = DM; }
        else if (mi < 12) { W = p.w_gu + (size_t)(mi - 8) * DM * NGU; WT = (bf16*)(ws + WS_W_GU) + (size_t)(mi - 8) * NGU * DM; K = DM; N = NGU; Npad = NGU; mode = 1; }
        else              { W = p.w_dn + (size_t)(mi - 12) * DFF * DM; WT = (bf16*)(ws + WS_W_DN) + (size_t)(mi - 12) * DM * DFF; K = DFF; N = DM; Npad = DM; }
        const int items = (K / 64) * (Npad / 32);
        for (int it = gw; it < items; it += NGW) conv_item(W, K, N, Npad, WT, mode, scr, it, lane);
    }
    bf16* XB = (bf16*)(ws + WS_XB);
    for (int m = gw; m < MTOK; m += NGW) {
        const GAS f32x4* xr = (const GAS f32x4*)(p.x + (size_t)m * DM) + lane; GAS u64* o8 = (GAS u64*)(XB + (size_t)m * DM) + lane;
#pragma unroll
        for (int j = 0; j < 8; ++j) { const f32x4 v = xr[64 * j]; o8[64 * j] = (u64)pk2(v.x, v.y) | ((u64)pk2(v.z, v.w) << 32); }
    }
}

__device__ __forceinline__ void ln_phase(const float* Z, const float* g, const float* b, float* Xo, bf16* XBo, int gw, int NGW, int lane) {
    OPAQUE_V(lane); OPAQUE_S(gw);
    for (int m = gw; m < MTOK; m += NGW) {
        const GAS f32x4* zr = (const GAS f32x4*)(Z + (size_t)m * DM) + lane;
        f32x4 v[8]; float s = 0.f;
#pragma unroll
        for (int j = 0; j < 8; ++j) { v[j] = zr[64 * j]; s += (v[j].x + v[j].y) + (v[j].z + v[j].w); }
        const float mean = wave_sum(s) * (1.f / DM); float s2 = 0.f;
#pragma unroll
        for (int j = 0; j < 8; ++j) { v[j] = v[j] - mean; s2 += (v[j].x * v[j].x + v[j].y * v[j].y) + (v[j].z * v[j].z + v[j].w * v[j].w); }
        const float rstd = 1.f / sqrtf(wave_sum(s2) * (1.f / DM) + LN_EPS);
        GAS f32x4* xo = (GAS f32x4*)(Xo + (size_t)m * DM) + lane; GAS u64* o8 = (GAS u64*)(XBo + (size_t)m * DM) + lane;
#pragma unroll
        for (int j = 0; j < 8; ++j) { const f32x4 gg = ((const f32x4*)g)[lane + 64 * j], bb = ((const f32x4*)b)[lane + 64 * j];
            const f32x4 y = v[j] * rstd * gg + bb; xo[64 * j] = y; o8[64 * j] = (u64)pk2(y.x, y.y) | ((u64)pk2(y.z, y.w) << 32); }
    }
}

__device__ __forceinline__ void load_row64(const bf16* p, float (&f)[64]) {
    const GAS v4u* q = (const GAS v4u*)p;
#pragma unroll
    for (int i = 0; i < 8; ++i) { const v4u w = q[i];
        f[8 * i + 0] = bf_lo(w.x); f[8 * i + 1] = bf_hi(w.x); f[8 * i + 2] = bf_lo(w.y); f[8 * i + 3] = bf_hi(w.y);
        f[8 * i + 4] = bf_lo(w.z); f[8 * i + 5] = bf_hi(w.z); f[8 * i + 6] = bf_lo(w.w); f[8 * i + 7] = bf_hi(w.w); }
}
__device__ __forceinline__ void attn_key(const float (&q)[64], const bf16* kp, const bf16* vp, float bias, float (&o)[64], float& m, float& l) {
    float s0 = 0.f, s1 = 0.f;
    { const GAS v4u* kq = (const GAS v4u*)kp;
#pragma unroll
      for (int i = 0; i < 8; ++i) { const v4u w = kq[i];
        s0 += q[8 * i + 0] * bf_lo(w.x); s1 += q[8 * i + 1] * bf_hi(w.x); s0 += q[8 * i + 2] * bf_lo(w.y); s1 += q[8 * i + 3] * bf_hi(w.y);
        s0 += q[8 * i + 4] * bf_lo(w.z); s1 += q[8 * i + 5] * bf_hi(w.z); s0 += q[8 * i + 6] * bf_lo(w.w); s1 += q[8 * i + 7] * bf_hi(w.w); } }
    const float s = (s0 + s1) + bias;
    if (s > m) { const float f = __builtin_amdgcn_exp2f(m - s); l *= f;
#pragma unroll
        for (int i = 0; i < 64; ++i) o[i] *= f;
        m = s; }
    const float pp = __builtin_amdgcn_exp2f(s - m); l += pp;
    { const GAS v4u* vq = (const GAS v4u*)vp;
#pragma unroll
      for (int i = 0; i < 8; ++i) { const v4u w = vq[i];
        o[8 * i + 0] += pp * bf_lo(w.x); o[8 * i + 1] += pp * bf_hi(w.x); o[8 * i + 2] += pp * bf_lo(w.y); o[8 * i + 3] += pp * bf_hi(w.y);
        o[8 * i + 4] += pp * bf_lo(w.z); o[8 * i + 5] += pp * bf_hi(w.z); o[8 * i + 6] += pp * bf_lo(w.w); o[8 * i + 7] += pp * bf_hi(w.w); } }
}
__device__ __forceinline__ void naive_attn_phase(int kind, const bf16* QKV, int pitch, const float* sinks, const unsigned* mask32, bf16* O, int gw, int NGW, int lane) {
    OPAQUE_V(lane); OPAQUE_S(gw);
    for (int task = gw; task < BATCH * 64 * NH; task += NGW) {
        const int h = task & 31, tb = (task >> 5) & 63, b = task >> 11;
        const int t = tb * 64 + lane; const size_t row = (size_t)b * SEQ + t; const int kvh = h >> 3;
        const float slope = exp2f(-0.25f * (float)(h + 1)) * LOG2E;
        float o[64];
#pragma unroll
        for (int i = 0; i < 64; ++i) o[i] = 0.f;
        float m = -INFINITY, l = 0.f;
        if (kind == 0) { m = sinks[h] * LOG2E; l = 1.f; }
        const int ng = (kind == 1) ? 3 : 1;
        for (int g = 0; g < ng; ++g) {
            float q[64]; load_row64(QKV + row * pitch + g * A_IN + h * HD, q);
            const bf16* kbase = QKV + (size_t)b * SEQ * pitch + g * A_IN + QD + kvh * HD;
            if (kind != 2) {
                const int d = (g == 0) ? 1 : (g == 1 ? 4 : 16); const int W = (kind == 0) ? 128 : 129;
                for (int j = 0; j < W; ++j) { const int pos = t - j * d;
                    if (pos >= 0) { const bf16* kp = kbase + (size_t)pos * pitch; attn_key(q, kp, kp + KVD, -slope * (float)(j * d), o, m, l); } }
            } else {
                const unsigned* mr = mask32 + row * 128;
                for (int w = 0; w <= (t >> 5); ++w) { unsigned bits = mr[w];
                    while (bits) { const int i = __builtin_ctz(bits); bits &= bits - 1u; const int pos = 32 * w + i;
                        const bf16* kp = kbase + (size_t)pos * pitch; attn_key(q, kp, kp + KVD, -slope * (float)(t - pos), o, m, l); } }
            }
        }
        const float rl = 1.f / l; GAS v4u* op = (GAS v4u*)(O + row * QD + h * HD);
#pragma unroll
        for (int i = 0; i < 8; ++i) { v4u w; w.x = pk2(o[8 * i] * rl, o[8 * i + 1] * rl); w.y = pk2(o[8 * i + 2] * rl, o[8 * i + 3] * rl);
            w.z = pk2(o[8 * i + 4] * rl, o[8 * i + 5] * rl); w.w = pk2(o[8 * i + 6] * rl, o[8 * i + 7] * rl); op[i] = w; }
    }
}

__device__ __forceinline__ void naive_score_phase(const bf16* P, float* SC, LAS unsigned char* lds, int gw, int NGW, int wave, int lane) {
    OPAQUE_V(lane); OPAQUE_S(gw); OPAQUE_S(wave);
    LAS float* qs = (LAS float*)(lds + wave * 8192);
    LAS float* wsc = qs + IDXH * IDXD;
    for (int it = gw; it < 2 * SEQ; it += NGW) {
        const int i = it / (SEQ / 2), w = it % (SEQ / 2);
        const int base = (i >> 1) * SEQ; const int t = (i & 1) ? (SEQ - 1 - w) : w;
        const size_t row = (size_t)base + t;
        { const GAS v4u* qp = (const GAS v4u*)(P + row * C_INP + C_QI) + 2 * lane;
          const v4u a = qp[0], c = qp[1]; LAS float* d = qs + 16 * lane;
          d[0] = bf_lo(a.x); d[1] = bf_hi(a.x); d[2] = bf_lo(a.y); d[3] = bf_hi(a.y); d[4] = bf_lo(a.z); d[5] = bf_hi(a.z); d[6] = bf_lo(a.w); d[7] = bf_hi(a.w);
          d[8] = bf_lo(c.x); d[9] = bf_hi(c.x); d[10] = bf_lo(c.y); d[11] = bf_hi(c.y); d[12] = bf_lo(c.z); d[13] = bf_hi(c.z); d[14] = bf_lo(c.w); d[15] = bf_hi(c.w);
          if (lane < IDXH) { const unsigned short wv = *(const GAS unsigned short*)(P + row * C_INP + C_WI + lane); wsc[lane] = __uint_as_float((unsigned)wv << 16) * (0.25f * 0.125f); } }
        LDS_WAIT(); asm volatile("" ::: "memory");
        for (int kb = 0; kb <= (t >> 6); ++kb) {
            const int s = kb * 64 + lane; float kf[64]; load_row64(P + ((size_t)base + s) * C_INP + C_KI, kf);
            float sc = 0.f;
            for (int h = 0; h < IDXH; ++h) { float a0 = 0.f, a1 = 0.f;
#pragma unroll
                for (int d = 0; d < 64; d += 2) { a0 += qs[h * 64 + d] * kf[d]; a1 += qs[h * 64 + d + 1] * kf[d + 1]; }
                sc += wsc[h] * fmaxf(a0 + a1, 0.f); }
            SC[row * SEQ + s] = sc;
        }
        LDS_WAIT(); asm volatile("" ::: "memory");
    }
}

__device__ __forceinline__ unsigned fkey(float f) { const unsigned u = __float_as_uint(f); return (u & 0x80000000u) ? ~u : (u | 0x80000000u); }
__device__ __forceinline__ void select_phase(const float* SC, u64* MASK, int gw, int NGW, int lane) {
    OPAQUE_V(lane); OPAQUE_S(gw);
    for (int row = gw; row < MTOK; row += NGW) {
        const int t = row & (SEQ - 1); const int nblk = (t >> 6) + 1;
        const float* sr = SC + (size_t)row * SEQ;
        u64* mrow = MASK + (size_t)row * 64;
        if (t < TOPK) {
            for (int i = 0; i < nblk; ++i) { const u64 bits = __ballot(64 * i + lane <= t); if (lane == 0) mrow[i] = bits; }
            continue;
        }
        unsigned u[64];
#pragma unroll
        for (int i = 0; i < 64; ++i) { const int e = 64 * i + lane; u[i] = 0u; if (i < nblk) { if (e <= t) u[i] = fkey(sr[e]); } }
        unsigned T = 0u;
        for (int bit = 31; bit >= 0; --bit) {
            const unsigned cand = T | (1u << bit); unsigned c = 0u;
#pragma unroll
            for (int i = 0; i < 64; ++i) c += (u[i] >= cand) ? 1u : 0u;
            c = wave_sum_u(c);
            if (c >= (unsigned)TOPK) T = cand;
        }
        unsigned cg = 0u;
#pragma unroll
        for (int i = 0; i < 64; ++i) cg += (u[i] > T) ? 1u : 0u;
        cg = wave_sum_u(cg);
        const unsigned need = (unsigned)TOPK - cg; unsigned run = 0u;
        const u64 ltmask = (lane == 0) ? 0ull : (~0ull >> (64 - lane));
#pragma unroll
        for (int i = 0; i < 64; ++i) {
            if (i < nblk) {
                const bool gt = u[i] > T, eq = u[i] == T; const u64 eqm = __ballot(eq);
                const unsigned rank = run + (unsigned)__popcll(eqm & ltmask);
                const u64 bits = __ballot(gt || (eq && rank < need)); run += (unsigned)__popcll(eqm);
                if (lane == 0) mrow[i] = bits;
            }
        }
    }
}

constexpr int NPH = 1 + 9 * DEPTH;
__host__ __device__ inline bool phase_exists(int k) { if (k == 0) return true; const int l = (k - 1) / 9, j = (k - 1) % 9; return (j == 1 || j == 2) ? (l % 3 == 2) : true; }

__global__ void __launch_bounds__(NWAVES * 64, 2) fwd_kernel(Params p) {
    extern __shared__ __attribute__((aligned(16))) unsigned char lds_raw[];
    LAS unsigned char* lds = (LAS unsigned char*)lds_raw;
    volatile LAS unsigned* MISC = (volatile LAS unsigned*)(lds + MISC_OFF);
    const int tid = threadIdx.x, lane = tid & 63, wave = __builtin_amdgcn_readfirstlane(tid >> 6);
    const int G = gridDim.x; const int gw = blockIdx.x * NWAVES + wave, NGW = G * NWAVES;
    unsigned char* ws = p.ws;
    gu32* ctl = (gu32*)(ws + WS_CTL);
    for (int u = tid; u < (LDS_BYTES - LDSCTL_OFF) / 4; u += NWAVES * 64) ((LAS unsigned*)(lds + LDSCTL_OFF))[u] = 0u;
    __syncthreads();
    const int lo = p.ph_lo, hi = p.ph_hi;
    XcdBarrier bar; bar.bar = (unsigned*)(ctl + CW_BAR) + p.li * XCD_BAR_WORDS; bar.x = 0; bar.st = nullptr;
    if (hi - lo > 1) bar = xcd_barrier_post((unsigned*)(ctl + CW_BAR) + p.li * XCD_BAR_WORDS, MISC + 8);
#define IN(k) (lo <= (k) && (k) < hi)
#define SEAM(k) do { if ((k) + 1 < hi) xcd_barrier(bar); } while (0)

    bf16* XB = (bf16*)(ws + WS_XB); float* X = (float*)(ws + WS_X); float* Z = (float*)(ws + WS_Z); bf16* O = (bf16*)(ws + WS_O);
    bf16* QKV = (bf16*)(ws + WS_QKV); bf16* H = (bf16*)(ws + WS_H); float* SC = (float*)(ws + WS_SC); u64* MASK = (u64*)(ws + WS_MASK);

    if (IN(0)) { prologue_phase(p, lds, gw, NGW, wave, lane); SEAM(0); }

    for (int l = 0; l < DEPTH; ++l) {
        const int kind = l % 3, jj = l / 3, pb = 1 + 9 * l;
        const bf16* Win; const bf16* Wout; int Nin;
        if (kind == 0)      { Win = (const bf16*)(ws + WS_W_AIN) + (size_t)jj * A_IN * DM; Wout = (const bf16*)(ws + WS_W_AOUT) + (size_t)jj * DM * QD; Nin = A_IN; }
        else if (kind == 1) { Win = (const bf16*)(ws + WS_W_BIN); Wout = (const bf16*)(ws + WS_W_BOUT); Nin = B_IN; }
        else                { Win = (const bf16*)(ws + WS_W_CIN); Wout = (const bf16*)(ws + WS_W_COUT); Nin = C_INP; }
        const float* xbase = (l == 0) ? p.x : X;

        if (IN(pb + 0)) {
            pg8::Gemm g{XB, Win, MTOK, Nin, DM}; pg8::StaticOrder S; S.init(MTOK, Nin, G, (int)blockIdx.x);
            pg8::EpiQKV E{QKV, Nin, (kind == 2) ? C_INP : A_IN, QD, C2};
            pg8::gemm_phase<pg8::EpiQKV, pg8::StaticOrder, true, true>(lds, g, S, E);
            SEAM(pb + 0);
        }
        if (kind == 2 && IN(pb + 1)) { naive_score_phase(QKV, SC, lds, gw, NGW, wave, lane); SEAM(pb + 1); }
        if (kind == 2 && IN(pb + 2)) { select_phase(SC, MASK, gw, NGW, lane); SEAM(pb + 2); }
        if (IN(pb + 3)) {
            naive_attn_phase(kind, QKV, Nin, p.a_sinks + jj * NH, (const unsigned*)MASK, O, gw, NGW, lane);
            SEAM(pb + 3);
        }
        if (IN(pb + 4)) {
            pg8::Gemm g{O, Wout, MTOK, DM, QD}; pg8::StaticOrder S; S.init(MTOK, DM, G, (int)blockIdx.x);
            pg8::EpiResid E{xbase, Z, DM, ALPHA};
            pg8::gemm_phase<pg8::EpiResid, pg8::StaticOrder, true, true>(lds, g, S, E);
            SEAM(pb + 4);
        }
        if (IN(pb + 5)) { ln_phase(Z, p.ln_g + (size_t)(2 * l) * DM, p.ln_b + (size_t)(2 * l) * DM, X, XB, gw, NGW, lane); SEAM(pb + 5); }
        if (IN(pb + 6)) {
            pg8::Gemm g{XB, (const bf16*)(ws + WS_W_GU) + (size_t)l * NGU * DM, MTOK, NGU, DM}; pg8::StaticOrder S; S.init(MTOK, NGU, G, (int)blockIdx.x);
            pg8::EpiSwiGLU E{H, DFF};
            pg8::gemm_phase<pg8::EpiSwiGLU, pg8::StaticOrder, true, true>(lds, g, S, E);
            SEAM(pb + 6);
        }
        if (IN(pb + 7)) {
            pg8::Gemm g{H, (const bf16*)(ws + WS_W_DN) + (size_t)l * DM * DFF, MTOK, DM, DFF}; pg8::StaticOrder S; S.init(MTOK, DM, G, (int)blockIdx.x);
            pg8::EpiResid E{X, Z, DM, ALPHA};
            pg8::gemm_phase<pg8::EpiResid, pg8::StaticOrder, true, true>(lds, g, S, E);
            SEAM(pb + 7);
        }
        if (IN(pb + 8)) { ln_phase(Z, p.ln_g + (size_t)(2 * l + 1) * DM, p.ln_b + (size_t)(2 * l + 1) * DM, (l == DEPTH - 1) ? p.out : X, XB, gw, NGW, lane); SEAM(pb + 8); }
    }
#undef IN
#undef SEAM
}

#ifndef MK_PER_PHASE
#define MK_PER_PHASE 0
#endif
extern "C" void kernel_launch(void* const* d_in, const int* in_sizes, int n_in, void* d_out, int out_size, void* d_ws, size_t ws_size, hipStream_t stream) {
    static int grid = 0;
    if (grid == 0) {
        if (n_in != 12 || in_sizes[0] != MTOK * DM || out_size != MTOK * DM || ws_size < WS_END) {
            fprintf(stderr, "kernel_launch: unexpected shapes (n_in %d, in0 %d, out %d, ws %zu < %zu?); nothing launched\n", n_in, n_in > 0 ? in_sizes[0] : -1, out_size, ws_size, (size_t)WS_END); grid = -1; return; }
        int dev = 0, cus = 0, per_cu = 0;
        if (hipGetDevice(&dev) != hipSuccess || hipDeviceGetAttribute(&cus, hipDeviceAttributeMultiprocessorCount, dev) != hipSuccess) { grid = -1; return; }
        if (hipFuncSetAttribute((const void*)fwd_kernel, hipFuncAttributeMaxDynamicSharedMemorySize, LDS_BYTES) != hipSuccess) { fprintf(stderr, "kernel_launch: hipFuncSetAttribute failed\n"); grid = -1; return; }
        if (hipOccupancyMaxActiveBlocksPerMultiprocessor(&per_cu, (const void*)fwd_kernel, NWAVES * 64, LDS_BYTES) != hipSuccess || per_cu < 1)
            fprintf(stderr, "kernel_launch: note: occupancy query reports %d workgroups per CU\n", per_cu);
        (void)hipGetLastError();
        grid = cus;
    }
    if (grid < 0) return;
    if (hipMemsetAsync((char*)d_ws + WS_CTL, 0, CTL_ZERO_BYTES, stream) != hipSuccess) { fprintf(stderr, "kernel_launch: hipMemsetAsync failed\n"); return; }
    Params a{};
    a.x = (const float*)d_in[0]; a.a_w_in = (const float*)d_in[1]; a.a_sinks = (const float*)d_in[2]; a.a_w_out = (const float*)d_in[3];
    a.b_w_in = (const float*)d_in[4]; a.b_w_out = (const float*)d_in[5]; a.c_w_in = (const float*)d_in[6]; a.c_w_out = (const float*)d_in[7];
    a.ln_g = (const float*)d_in[8]; a.ln_b = (const float*)d_in[9]; a.w_gu = (const float*)d_in[10]; a.w_dn = (const float*)d_in[11];
    a.out = (float*)d_out; a.ws = (unsigned char*)d_ws; a.pad = 0;
#if MK_PER_PHASE
    int li = 0;
    for (int k = 0; k < NPH; ++k) { if (!phase_exists(k)) continue; a.ph_lo = k; a.ph_hi = k + 1; a.li = li++;
        hipLaunchKernelGGL(fwd_kernel, dim3(grid), dim3(NWAVES * 64), LDS_BYTES, stream, a); }
#else
    a.ph_lo = 0; a.ph_hi = NPH; a.li = 0;
    hipLaunchKernelGGL(fwd_kernel, dim3(grid), dim3(NWAVES * 64), LDS_BYTES, stream, a);
#endif
    const hipError_t le = hipPeekAtLastError();
    if (le != hipSuccess) fprintf(stderr, "kernel_launch: launch failed: %s\n", hipGetErrorName(le));
}
```

```cpp
#include <hip/hip_runtime.h>
#include <cstdio>
#include <cstdint>
namespace pg8 {
#define PG8_LAS __attribute__((address_space(3)))
typedef unsigned short bf16_t;
typedef short bf16x8 __attribute__((ext_vector_type(8)));
typedef float f32x4 __attribute__((ext_vector_type(4)));
typedef unsigned u32x4 __attribute__((ext_vector_type(4)));
constexpr int BM = 256, BK = 64, HALF = 128, HTB = HALF * BK * 2  , STAGE_BYTES = 8 * HTB, NXCD = 8, WGM = 8;

__host__ __device__ __forceinline__ int lds_byte(int r, int c) { const int st = (r >> 4) * 2 + (c >> 5), rr = r & 15, cc = c & 31, ob = rr * 64 + cc * 2; return st * 1024 + (ob ^ (((ob >> 9) & 1) << 5)); }
__host__ __device__ __forceinline__ void stage_rc(int b, int& R, int& C) { const int st = b / 1024, sb = b % 1024, swz = sb ^ (((sb >> 9) & 1) << 5); R = (st >> 1) * 16 + swz / 64; C = (st & 1) * 32 + (swz % 64) / 2; }
__host__ __device__ __forceinline__ int perm32(int rho) { const int n = rho >> 4, i = rho & 15; return 8 * (i >> 2) + 4 * n + (i & 3); }

struct Unit { int pm, pn; };
struct Gemm { const bf16_t* A; const bf16_t* Bt; int M, N, K; };

struct StaticOrder {
    int nM, nN, nwg, G, c;
    __host__ __device__ void init(int M, int N, int G_, int c_) { nM = M / BM; nN = N / BM; nwg = nM * nN; G = G_; c = c_; }
    __host__ __device__ bool next(int i, Unit& u) const {
        const long L = (long)i * G + c; if (L >= nwg) return false;
        int wgid = (int)L; { const int q = nwg / NXCD, r = nwg % NXCD, xcd = wgid % NXCD, off = wgid / NXCD; wgid = (xcd < r ? xcd * (q + 1) : r * (q + 1) + (xcd - r) * q) + off; }
        const int nig = WGM * nN, gid = wgid / nig, fm = gid * WGM, gsz = (nM - fm) < WGM ? (nM - fm) : WGM;
        u.pm = fm + ((wgid % nig) % gsz); u.pn = (wgid % nig) / gsz; return true;
    }
    __device__ __forceinline__ void a_ready(const Unit&) const {}
    __device__ __forceinline__ void done(const Unit&) const {}
};


__device__ __forceinline__ unsigned cvt_pk_bf16(float lo, float hi) { unsigned r; asm volatile("v_cvt_pk_bf16_f32 %0, %1, %2" : "=v"(r) : "v"(lo), "v"(hi)); return r; }

struct EpiQKV {
    static constexpr bool PERM = true, AFTER_DRAIN = false;
    bf16_t* O; int ldc; int qmod, qlim; float qscale;
    __device__ __forceinline__ void operator()(const f32x4 (&acc)[2][2][4][2], const Unit& u, int wr, int wc, int fr, int fq) const {
        const int row0 = u.pm * BM + wr * 64 + fr; const int colt = u.pn * BM;
        const float sc = ((colt % qmod) < qlim) ? qscale : 1.f;
        const int col0 = colt + wc * 32 + 8 * fq;
#pragma unroll
        for (int ai = 0; ai < 2; ++ai)
#pragma unroll
            for (int m = 0; m < 4; ++m) { bf16_t* rowp = O + (size_t)(row0 + ai * HALF + m * 16) * ldc + col0;
#pragma unroll
                for (int bj = 0; bj < 2; ++bj) { f32x4 v0 = acc[ai][bj][m][0] * sc, v1 = acc[ai][bj][m][1] * sc;
                    u32x4 w; w.x = cvt_pk_bf16(v0[0], v0[1]); w.y = cvt_pk_bf16(v0[2], v0[3]); w.z = cvt_pk_bf16(v1[0], v1[1]); w.w = cvt_pk_bf16(v1[2], v1[3]);
                    *(u32x4*)(rowp + bj * HALF) = w; } }
    }
};
struct EpiSwiGLU {
    static constexpr bool PERM = true, AFTER_DRAIN = false;
    bf16_t* Hh; int ldc;
    __device__ __forceinline__ float sg(float g, float uu) const { const float e = __builtin_amdgcn_exp2f(g * -1.4426950408889634f); return g * __builtin_amdgcn_rcpf(1.0f + e) * uu; }
    __device__ __forceinline__ void operator()(const f32x4 (&acc)[2][2][4][2], const Unit& u, int wr, int wc, int fr, int fq) const {
        const int row0 = u.pm * BM + wr * 64 + fr; const int col0 = u.pn * HALF + wc * 32 + 8 * fq;
#pragma unroll
        for (int ai = 0; ai < 2; ++ai)
#pragma unroll
            for (int m = 0; m < 4; ++m) { bf16_t* rowp = Hh + (size_t)(row0 + ai * HALF + m * 16) * ldc + col0;
                const f32x4 g0 = acc[ai][0][m][0], g1 = acc[ai][0][m][1], u0 = acc[ai][1][m][0], u1 = acc[ai][1][m][1];
                u32x4 w; w.x = cvt_pk_bf16(sg(g0[0], u0[0]), sg(g0[1], u0[1])); w.y = cvt_pk_bf16(sg(g0[2], u0[2]), sg(g0[3], u0[3]));
                w.z = cvt_pk_bf16(sg(g1[0], u1[0]), sg(g1[1], u1[1])); w.w = cvt_pk_bf16(sg(g1[2], u1[2]), sg(g1[3], u1[3]));
                *(u32x4*)rowp = w; }
    }
};
struct EpiResid {
    static constexpr bool PERM = false, AFTER_DRAIN = false;
    const float* base; float* out; int ldc; float alpha;
    __device__ __forceinline__ void operator()(const f32x4 (&acc)[2][2][4][2], const Unit& u, int wr, int wc, int fr, int fq) const {
        const int row0 = u.pm * BM + wr * 64 + fr, col0 = u.pn * BM + wc * 32 + 4 * fq;
#pragma unroll
        for (int ai = 0; ai < 2; ++ai)
#pragma unroll
            for (int m = 0; m < 4; ++m) { const size_t off = (size_t)(row0 + ai * HALF + m * 16) * ldc + col0;
#pragma unroll
                for (int bj = 0; bj < 2; ++bj)
#pragma unroll
                    for (int n = 0; n < 2; ++n) { const f32x4 bs = *(const f32x4*)(base + off + bj * HALF + n * 16); *(f32x4*)(out + off + bj * HALF + n * 16) = bs * alpha + acc[ai][bj][m][n]; }
                asm volatile("" ::: "memory"); }
    }
};

template <class Epi, class Sched, bool ALIGN_EPI = false, bool SP2 = false>
__device__ __forceinline__ void gemm_phase(PG8_LAS unsigned char* lds, const Gemm g, const Sched& S, const Epi& E) {
    int tid_ = threadIdx.x; asm volatile("" : "+v"(tid_));
    const int tid = tid_, wid = __builtin_amdgcn_readfirstlane(tid >> 6), lane = tid & 63, wr = wid >> 2, wc = wid & 3, fr = lane & 15, fq = lane >> 4;
    const int K = g.K, nt = K / BK;
    unsigned voffA[2], voffB[2];
#pragma unroll
    for (int i = 0; i < 2; ++i) { int R, C; stage_rc(tid * 16 + i * 8192, R, C); const int Rb = Epi::PERM ? ((R & ~31) + perm32(R & 31)) : R;
        voffA[i] = (unsigned)(R * K + C) * 2u; voffB[i] = (unsigned)(Rb * K + C) * 2u; }
    const size_t kstep = (size_t)(BK * 2);
    const size_t hstep = (size_t)HALF * K * 2;
    const size_t tstep = 2 * hstep;
    const unsigned ldsw = (unsigned)wid * 1024u;
    const int aoff = lds_byte(wr * 64 + fr, fq * 8), boff = lds_byte(wc * 32 + fr, fq * 8);
#define PG8_SA(b, h) (((b) * 2 + (h)) * HTB)
#define PG8_SB(b, h) ((4 + (b) * 2 + (h)) * HTB)
#define PG8_STAGE(bufoff, gbase, voff) do { _Pragma("unroll") for (int _i = 0; _i < 2; ++_i) \
        __builtin_amdgcn_global_load_lds((const unsigned*)((const char*)(gbase) + (voff)[_i]), (PG8_LAS unsigned*)(lds + (bufoff) + ldsw + _i * 8192), 16, 0, 0); } while (0)
#define PG8_LDA(dst, b, h) do { _Pragma("unroll") for (int m = 0; m < 4; ++m) _Pragma("unroll") for (int k = 0; k < 2; ++k) dst[m][k] = *(const PG8_LAS bf16x8*)(lds + PG8_SA(b, h) + aoff + m * 2048 + k * 1024); } while (0)
#define PG8_LDB(dst, b, h) do { _Pragma("unroll") for (int n = 0; n < 2; ++n) _Pragma("unroll") for (int k = 0; k < 2; ++k) dst[n][k] = *(const PG8_LAS bf16x8*)(lds + PG8_SB(b, h) + boff + n * 2048 + k * 1024); } while (0)
#define PG8_MMA(ai, bj, At, Bt) do { __builtin_amdgcn_s_setprio(1); _Pragma("unroll") for (int m = 0; m < 4; ++m) _Pragma("unroll") for (int n = 0; n < 2; ++n) _Pragma("unroll") for (int k = 0; k < 2; ++k) \
        acc[ai][bj][m][n] = __builtin_amdgcn_mfma_f32_16x16x32_bf16(Bt[n][k], At[m][k], acc[ai][bj][m][n], 0, 0, 0); __builtin_amdgcn_s_setprio(0); } while (0)
#define PG8_WAIT_V(n) asm volatile("s_waitcnt vmcnt(" #n ")" ::: "memory")
#define PG8_WAIT_L(n) asm volatile("s_waitcnt lgkmcnt(" #n ")" ::: "memory")
#define PG8_BAR __builtin_amdgcn_s_barrier()
#define PG8_SCHED __builtin_amdgcn_sched_barrier(0)
    Unit cur, nxt; int ui = 0;
    if (!S.next(0, cur)) return;
    f32x4 acc[2][2][4][2];
#pragma unroll
    for (int a = 0; a < 2; ++a)
#pragma unroll
        for (int b = 0; b < 2; ++b)
#pragma unroll
            for (int m = 0; m < 4; ++m)
#pragma unroll
                for (int n = 0; n < 2; ++n) acc[a][b][m][n] = (f32x4){0.f, 0.f, 0.f, 0.f};
    bf16x8 At[4][2], B0[2][2], B1[2][2];
    const char* cA = (const char*)g.A + (size_t)cur.pm * tstep; const char* cB = (const char*)g.Bt + (size_t)cur.pn * tstep;
    S.a_ready(cur);
    if constexpr (SP2) {
        PG8_STAGE(PG8_SB(0, 0), cB, voffB); PG8_STAGE(PG8_SB(0, 1), cB + hstep, voffB); PG8_STAGE(PG8_SA(0, 0), cA, voffA); PG8_STAGE(PG8_SA(0, 1), cA + hstep, voffA);
        if (wr == 1) PG8_BAR;
        PG8_WAIT_V(2); PG8_BAR;
        PG8_STAGE(PG8_SB(1, 0), cB + kstep, voffB); PG8_STAGE(PG8_SA(1, 0), cA + kstep, voffA); PG8_STAGE(PG8_SB(1, 1), cB + hstep + kstep, voffB);
        PG8_WAIT_V(6); PG8_BAR;
    } else {
        PG8_STAGE(PG8_SB(0, 0), cB, voffB); PG8_STAGE(PG8_SA(0, 0), cA, voffA); PG8_STAGE(PG8_SB(0, 1), cB + hstep, voffB); PG8_STAGE(PG8_SA(0, 1), cA + hstep, voffA);
        if (wr == 1) PG8_BAR;
        PG8_WAIT_V(4); PG8_BAR;
        PG8_STAGE(PG8_SB(1, 0), cB + kstep, voffB); PG8_STAGE(PG8_SA(1, 0), cA + kstep, voffA); PG8_STAGE(PG8_SB(1, 1), cB + hstep + kstep, voffB);
        PG8_WAIT_V(6); PG8_BAR;
    }
    for (;;) {
        const bool has_next = S.next(ui + 1, nxt);
        const char* nA = has_next ? (const char*)g.A + (size_t)nxt.pm * tstep : cA; const char* nB = has_next ? (const char*)g.Bt + (size_t)nxt.pn * tstep : cB;
        for (int t = 0; t < nt; t += 2) {
            const bool last = (t == nt - 2);
            const char* a1 = cA + (size_t)(t + 1) * kstep;
            const char* a2 = last ? nA : cA + (size_t)(t + 2) * kstep; const char* b2 = last ? nB : cB + (size_t)(t + 2) * kstep;
            const char* a3 = a2 + kstep; const char* b3 = b2 + kstep;
            if (last && has_next) S.a_ready(nxt);
            if constexpr (SP2) {
            PG8_LDB(B0, 0, 0); PG8_LDB(B1, 0, 1); PG8_SCHED; PG8_LDA(At, 0, 0); PG8_STAGE(PG8_SA(1, 1), a1 + hstep, voffA);
            PG8_WAIT_V(8); PG8_WAIT_L(0); PG8_BAR; PG8_MMA(0, 0, At, B0); PG8_MMA(0, 1, At, B1); PG8_BAR; PG8_SCHED;
            PG8_LDA(At, 0, 1); PG8_STAGE(PG8_SB(0, 0), b2, voffB); PG8_STAGE(PG8_SB(0, 1), b2 + hstep, voffB); PG8_STAGE(PG8_SA(0, 0), a2, voffA);
            PG8_WAIT_V(8); PG8_WAIT_L(0); PG8_BAR; PG8_MMA(1, 0, At, B0); PG8_MMA(1, 1, At, B1); PG8_BAR; PG8_SCHED;
            PG8_LDB(B0, 1, 0); PG8_LDB(B1, 1, 1); PG8_SCHED; PG8_LDA(At, 1, 0); PG8_STAGE(PG8_SA(0, 1), a2 + hstep, voffA);
            PG8_WAIT_V(8); PG8_WAIT_L(0); PG8_BAR; PG8_MMA(0, 0, At, B0); PG8_MMA(0, 1, At, B1); PG8_BAR; PG8_SCHED;
            PG8_LDA(At, 1, 1); PG8_STAGE(PG8_SB(1, 0), b3, voffB); PG8_STAGE(PG8_SB(1, 1), b3 + hstep, voffB); PG8_STAGE(PG8_SA(1, 0), a3, voffA);
            PG8_WAIT_V(8); PG8_WAIT_L(0); PG8_BAR; PG8_MMA(1, 0, At, B0); PG8_MMA(1, 1, At, B1); PG8_BAR; PG8_SCHED;
            } else {
            PG8_LDB(B0, 0, 0); PG8_SCHED; PG8_LDA(At, 0, 0); PG8_STAGE(PG8_SA(1, 1), a1 + hstep, voffA);
            PG8_WAIT_L(8); PG8_BAR; PG8_WAIT_L(0); PG8_MMA(0, 0, At, B0); PG8_BAR; PG8_SCHED;
            PG8_LDB(B1, 0, 1); PG8_STAGE(PG8_SB(0, 0), b2, voffB);
            PG8_BAR; PG8_WAIT_L(0); PG8_MMA(0, 1, At, B1); PG8_BAR;
            PG8_LDA(At, 0, 1); PG8_STAGE(PG8_SA(0, 0), a2, voffA);
            PG8_BAR; PG8_WAIT_L(0); PG8_MMA(1, 0, At, B0); PG8_BAR; PG8_SCHED;
            PG8_STAGE(PG8_SB(0, 1), b2 + hstep, voffB);
            PG8_WAIT_V(6); PG8_BAR; PG8_MMA(1, 1, At, B1); PG8_BAR;
            PG8_LDB(B0, 1, 0); PG8_SCHED; PG8_LDA(At, 1, 0); PG8_STAGE(PG8_SA(0, 1), a2 + hstep, voffA);
            PG8_WAIT_L(8); PG8_BAR; PG8_WAIT_L(0); PG8_MMA(0, 0, At, B0); PG8_BAR; PG8_SCHED;
            PG8_LDB(B1, 1, 1); PG8_STAGE(PG8_SB(1, 0), b3, voffB);
            PG8_BAR; PG8_WAIT_L(0); PG8_MMA(0, 1, At, B1); PG8_BAR;
            PG8_LDA(At, 1, 1); PG8_STAGE(PG8_SA(1, 0), a3, voffA);
            PG8_BAR; PG8_WAIT_L(0); PG8_MMA(1, 0, At, B0); PG8_BAR; PG8_SCHED;
            PG8_STAGE(PG8_SB(1, 1), b3 + hstep, voffB);
            PG8_WAIT_V(6); PG8_BAR; PG8_MMA(1, 1, At, B1); PG8_BAR;
            }
        }
        if constexpr (ALIGN_EPI) { if (wr == 0) PG8_BAR; }
        if constexpr (!Epi::AFTER_DRAIN) { E(acc, cur, wr, wc, fr, fq); S.done(cur); }
        if (!has_next) break;
#pragma unroll
        for (int a = 0; a < 2; ++a)
#pragma unroll
            for (int b = 0; b < 2; ++b)
#pragma unroll
                for (int m = 0; m < 4; ++m)
#pragma unroll
                    for (int n = 0; n < 2; ++n) acc[a][b][m][n] = (f32x4){0.f, 0.f, 0.f, 0.f};
        cur = nxt; cA = nA; cB = nB; ++ui;
        if constexpr (ALIGN_EPI) { if (wr == 1) PG8_BAR; }
    }
    PG8_WAIT_V(0);
    if constexpr (!ALIGN_EPI) { if (wr == 0) PG8_BAR; }
    PG8_BAR;
    if constexpr (Epi::AFTER_DRAIN) { E.fused(acc, cur, wr, wc, fr, fq, lds, wid, lane); S.done(cur); }
#undef PG8_SA
#undef PG8_SB
#undef PG8_STAGE
#undef PG8_LDA
#undef PG8_LDB
#undef PG8_MMA
#undef PG8_WAIT_V
#undef PG8_WAIT_L
#undef PG8_BAR
#undef PG8_SCHED
}
}
#define GAS __attribute__((address_space(1)))
#define LAS __attribute__((address_space(3)))
typedef unsigned short bf16;
typedef unsigned v4u __attribute__((ext_vector_type(4)));
typedef float f32x4 __attribute__((ext_vector_type(4)));
typedef short bf16x8 __attribute__((ext_vector_type(8)));
typedef GAS unsigned gu32;
typedef GAS unsigned long long gu64;
#define RLX_AGENT __ATOMIC_RELAXED, __HIP_MEMORY_SCOPE_AGENT
#define LDS_WAIT() asm volatile("s_waitcnt lgkmcnt(0)" ::: "memory")
#define VM_WAIT() asm volatile("s_waitcnt vmcnt(0)" ::: "memory")
__device__ __forceinline__ unsigned long long rt() { return __builtin_amdgcn_s_memrealtime(); }
__device__ __forceinline__ unsigned f2bf(float f) { unsigned u = __builtin_bit_cast(unsigned, f); return (u + 0x7fffu + ((u >> 16) & 1u)) >> 16; }
__device__ __forceinline__ unsigned pk2(float lo, float hi) { return f2bf(lo) | (f2bf(hi) << 16); }

#define XB_TMO      128
#define XB_XCNT(j)  (256  + 64 * (j))
#define XB_XSUB(j)  (1280 + 64 * (j))
#define XB_XGEN(j)  (2304 + 64 * (j))
#define XB_TOP      3328
#define XB_TOPGEN   3392
#define XCD_BAR_WORDS 3456
#define XB_SPIN_CAP (1u << 18)

__device__ __forceinline__ unsigned xb_ld(unsigned* p)              { return __hip_atomic_load(p, __ATOMIC_RELAXED, __HIP_MEMORY_SCOPE_AGENT); }
__device__ __forceinline__ unsigned xb_add(unsigned* p, unsigned v) { return __hip_atomic_fetch_add(p, v, __ATOMIC_RELAXED, __HIP_MEMORY_SCOPE_AGENT); }
__device__ __forceinline__ unsigned xb_xcc_id() { return (unsigned)__builtin_amdgcn_s_getreg((3 << 11) | 20) & 0xFu; }
#define XB_SPIN(cond, bar) do { unsigned _sp = 0; while (cond) { __builtin_amdgcn_s_sleep(1); \
    if ((++_sp & 255u) == 0u) { if (xb_ld(&(bar)[XB_TMO])) break; if (_sp > XB_SPIN_CAP) { atomicAdd(&(bar)[XB_TMO], 1u); break; } } } } while (0)

struct XcdBarrier {
    unsigned* bar; unsigned x;
    volatile LAS unsigned* st;
};

__device__ __forceinline__ XcdBarrier xcd_barrier_post(unsigned* bar, volatile LAS unsigned* st) {
    XcdBarrier b; b.bar = bar; b.x = xb_xcc_id(); b.st = st;
    if (threadIdx.x == 0) (void)xb_add(&bar[XB_XCNT(b.x)], 1u);
    return b;
}
__device__ __forceinline__ void xcd_barrier_complete(unsigned* bar, unsigned x, unsigned& nloc, unsigned& nx) {
    const unsigned G = gridDim.x * gridDim.y * gridDim.z;
    unsigned sum, cnt, mine, sp = 0u;
    for (;;) {
        sum = 0u; cnt = 0u; mine = 0u;
#pragma unroll
        for (unsigned j = 0; j < 16; ++j) { const unsigned c = xb_ld(&bar[XB_XCNT(j)]); sum += c; cnt += (c > 0u) ? 1u : 0u; mine = (j == x) ? c : mine; }
        if (sum == G) break;
        __builtin_amdgcn_s_sleep(1);
        if ((++sp & 255u) == 0u) { if (xb_ld(&bar[XB_TMO])) break; if (sp > XB_SPIN_CAP) { atomicAdd(&bar[XB_TMO], 1u); break; } }
    }
    nloc = mine > 0u ? mine : 1u; nx = cnt > 0u ? cnt : 1u;
}

__device__ __forceinline__ void xcd_barrier(const XcdBarrier& b) {
    asm volatile("s_waitcnt vmcnt(0)" ::: "memory");
    __syncthreads();
    if (threadIdx.x == 0) {
        unsigned* bar = b.bar;
        __builtin_amdgcn_s_waitcnt(0);
        unsigned nloc = b.st[0], nx = b.st[1];
        if (nloc == 0u) { xcd_barrier_complete(bar, b.x, nloc, nx); b.st[0] = nloc; b.st[1] = nx; }
        const unsigned old = xb_add(&bar[XB_XSUB(b.x)], 1u);
        const unsigned gen = old / nloc;
        if (old + 1u == (gen + 1u) * nloc) {
            __builtin_amdgcn_fence(__ATOMIC_RELEASE, "agent");
            asm volatile("s_waitcnt vmcnt(0)" ::: "memory");
            const unsigned og = xb_add(&bar[XB_TOP], 1u);
            const unsigned tg = og / nx;
            if (og + 1u == (tg + 1u) * nx) xb_add(&bar[XB_TOPGEN], 1u);
            else XB_SPIN(xb_ld(&bar[XB_TOPGEN]) == tg, bar);
            __builtin_amdgcn_fence(__ATOMIC_ACQUIRE, "agent");
            xb_add(&bar[XB_XGEN(b.x)], 1u);
            asm volatile("s_waitcnt vmcnt(0)" ::: "memory");
        } else {
            XB_SPIN(xb_ld(&bar[XB_XGEN(b.x)]) == gen, bar);
            __builtin_amdgcn_fence(__ATOMIC_ACQUIRE, "agent");
            asm volatile("s_waitcnt vmcnt(0)" ::: "memory");
        }
    }
    __syncthreads();
}

constexpr int BATCH = 2, SEQ = 4096, DM = 2048, MTOK = BATCH * SEQ, DEPTH = 4;
constexpr int NH = 32, NKV = 4, HD = 64, QD = 2048, KVD = 256;
constexpr int A_IN = 2560, B_IN = 7680, C_IN = 3664, C_INP = 3840;
constexpr int DFF = 5632, NGU = 2 * DFF;
constexpr int IDXH = 16, IDXD = 64, TOPK = 256;
constexpr int C_QI = 2560, C_KI = 3584, C_WI = 3648;
constexpr float ALPHA = 1.6817928305074290f;
constexpr float LN_EPS = 1e-5f;
constexpr float LOG2E = 1.4426950408889634f;
constexpr float C2 = 0.125f * LOG2E;

constexpr size_t MiB = 1u << 20;
constexpr size_t WS_CTL = 0, CTL_ZERO_BYTES = 1 * MiB;
constexpr size_t WS_W_AIN = 2 * MiB;
constexpr size_t WS_W_AOUT = WS_W_AIN + 20 * MiB;
constexpr size_t WS_W_BIN = WS_W_AOUT + 16 * MiB;
constexpr size_t WS_W_BOUT = WS_W_BIN + 30 * MiB;
constexpr size_t WS_W_CIN = WS_W_BOUT + 8 * MiB;
constexpr size_t WS_W_COUT = WS_W_CIN + 15 * MiB;
constexpr size_t WS_W_GU = WS_W_COUT + 8 * MiB;
constexpr size_t WS_W_DN = WS_W_GU + 176 * MiB;
constexpr size_t WS_X = WS_W_DN + 88 * MiB;
constexpr size_t WS_XB = WS_X + 64 * MiB;
constexpr size_t WS_Z = WS_XB + 32 * MiB;
constexpr size_t WS_O = WS_Z + 64 * MiB;
constexpr size_t WS_MASK = WS_O + 32 * MiB;
constexpr size_t WS_QKV = WS_MASK + 4 * MiB;
constexpr size_t WS_H = WS_QKV + 120 * MiB;
constexpr size_t WS_SC = WS_H;
constexpr size_t WS_END = WS_H + 128 * MiB;
constexpr int CW_BAR = 4096;

constexpr int RING_BYTES = 131072;
constexpr int LDSCTL_OFF = RING_BYTES, MISC_OFF = LDSCTL_OFF + 320;
constexpr int LDS_BYTES = 147456;
constexpr int NWAVES = 8;

typedef unsigned long long u64;
#define OPAQUE_V(x) asm volatile("" : "+v"(x))
#define OPAQUE_S(x) asm volatile("" : "+s"(x))

__device__ __forceinline__ float bf_lo(unsigned u) { return __uint_as_float(u << 16); }
__device__ __forceinline__ float bf_hi(unsigned u) { return __uint_as_float(u & 0xffff0000u); }
__device__ __forceinline__ float wave_sum(float v) {
#pragma unroll
    for (int o = 1; o < 64; o <<= 1) v += __shfl_xor(v, o);
    return v;
}
__device__ __forceinline__ unsigned wave_sum_u(unsigned v) {
#pragma unroll
    for (int o = 1; o < 64; o <<= 1) v += (unsigned)__shfl_xor((int)v, o);
    return v;
}

__device__ __forceinline__ void conv_item(const float* W, int K, int N, int Npad, bf16* WT, int mode, LAS float* scr, int item, int lane) {
    const int nblk = Npad / 32, kb = item / nblk, nb = item % nblk, k0 = 64 * kb, n0 = 32 * nb;
    const int ncol = n0 + (lane & 31); const bool nok = ncol < N;
#pragma unroll 8
    for (int i = 0; i < 32; ++i) { const int kk = 2 * i + (lane >> 5); scr[kk * 33 + (lane & 31)] = nok ? W[(size_t)(k0 + kk) * N + ncol] : 0.f; }
    LDS_WAIT(); asm volatile("" ::: "memory");
    int row0 = n0;
    if (mode == 1) { if (n0 < DFF) row0 = 256 * (n0 / 128) + (n0 % 128); else { const int c = n0 - DFF; row0 = 256 * (c / 128) + 128 + (c % 128); } }
    const int c = lane & 7;
#pragma unroll
    for (int j = 0; j < 4; ++j) { const int n = (lane >> 3) + 8 * j; const LAS float* s = scr + (8 * c) * 33 + n;
        v4u o; o.x = pk2(s[0 * 33], s[1 * 33]); o.y = pk2(s[2 * 33], s[3 * 33]); o.z = pk2(s[4 * 33], s[5 * 33]); o.w = pk2(s[6 * 33], s[7 * 33]);
        *(GAS v4u*)(WT + (size_t)(row0 + n) * K + k0 + 8 * c) = o; }
    LDS_WAIT(); asm volatile("" ::: "memory");
}

struct Params {
    const float* x; const float* a_w_in; const float* a_sinks; const float* a_w_out; const float* b_w_in; const float* b_w_out;
    const float* c_w_in; const float* c_w_out; const float* ln_g; const float* ln_b; const float* w_gu; const float* w_dn;
    float* out; unsigned char* ws;
    int ph_lo, ph_hi, li, pad;
};

__device__ __forceinline__ void prologue_phase(const Params& p, LAS unsigned char* lds, int gw, int NGW, int wave, int lane) {
    OPAQUE_V(lane); OPAQUE_S(gw); OPAQUE_S(wave);
    LAS float* scr = (LAS float*)(lds + wave * 16384);
    unsigned char* ws = p.ws;
    for (int mi = 0; mi < 16; ++mi) {
        const float* W; bf16* WT; int K, N, Npad, mode = 0;
        if (mi < 2)       { W = p.a_w_in + (size_t)mi * DM * A_IN;  WT = (bf16*)(ws + WS_W_AIN) + (size_t)mi * A_IN * DM;  K = DM; N = A_IN; Npad = A_IN; }
        else if (mi < 4)  { W = p.a_w_out + (size_t)(mi - 2) * QD * DM; WT = (bf16*)(ws + WS_W_AOUT) + (size_t)(mi - 2) * DM * QD; K = QD; N = DM; Npad = DM; }
        else if (mi == 4) { W = p.b_w_in;  WT = (bf16*)(ws + WS_W_BIN);  K = DM; N = B_IN; Npad = B_IN; }
        else if (mi == 5) { W = p.b_w_out; WT = (bf16*)(ws + WS_W_BOUT); K = QD; N = DM; Npad = DM; }
        else if (mi == 6) { W = p.c_w_in;  WT = (bf16*)(ws + WS_W_CIN);  K = DM; N = C_IN; Npad = C_INP; }
        else if (mi == 7) { W = p.c_w_out; WT = (bf16*)(ws + WS_W_COUT); K = QD; N = DM; Npad = DM; }
        else if (mi < 12) { W = p.w_gu + (size_t)(mi - 8) * DM * NGU; WT = (bf16*)(ws + WS_W_GU) + (size_t)(mi - 8) * NGU * DM; K = DM; N = NGU; Npad = NGU; mode = 1; }
        else              { W = p.w_dn + (size_t)(mi - 12) * DFF * DM; WT = (bf16*)(ws + WS_W_DN) + (size_t)(mi - 12) * DM * DFF; K = DFF; N = DM; Npad = DM; }
        const int items = (K / 64) * (Npad / 32);
        for (int it = gw; it < items; it += NGW) conv_item(W, K, N, Npad, WT, mode, scr, it, lane);
    }
    bf16* XB = (bf16*)(ws + WS_XB);
    for (int m = gw; m < MTOK; m += NGW) {
        const GAS f32x4* xr = (const GAS f32x4*)(p.x + (size_t)m * DM) + lane; GAS u64* o8 = (GAS u64*)(XB + (size_t)m * DM) + lane;
#pragma unroll
        for (int j = 0; j < 8; ++j) { const f32x4 v = xr[64 * j]; o8[64 * j] = (u64)pk2(v.x, v.y) | ((u64)pk2(v.z, v.w) << 32); }
    }
}

__device__ __forceinline__ void ln_phase(const float* Z, const float* g, const float* b, float* Xo, bf16* XBo, int gw, int NGW, int lane) {
    OPAQUE_V(lane); OPAQUE_S(gw);
    for (int m = gw; m < MTOK; m += NGW) {
        const GAS f32x4* zr = (const GAS f32x4*)(Z + (size_t)m * DM) + lane;
        f32x4 v[8]; float s = 0.f;
#pragma unroll
        for (int j = 0; j < 8; ++j) { v[j] = zr[64 * j]; s += (v[j].x + v[j].y) + (v[j].z + v[j].w); }
        const float mean = wave_sum(s) * (1.f / DM); float s2 = 0.f;
#pragma unroll
        for (int j = 0; j < 8; ++j) { v[j] = v[j] - mean; s2 += (v[j].x * v[j].x + v[j].y * v[j].y) + (v[j].z * v[j].z + v[j].w * v[j].w); }
        const float rstd = 1.f / sqrtf(wave_sum(s2) * (1.f / DM) + LN_EPS);
        GAS f32x4* xo = (GAS f32x4*)(Xo + (size_t)m * DM) + lane; GAS u64* o8 = (GAS u64*)(XBo + (size_t)m * DM) + lane;
#pragma unroll
        for (int j = 0; j < 8; ++j) { const f32x4 gg = ((const f32x4*)g)[lane + 64 * j], bb = ((const f32x4*)b)[lane + 64 * j];
            const f32x4 y = v[j] * rstd * gg + bb; xo[64 * j] = y; o8[64 * j] = (u64)pk2(y.x, y.y) | ((u64)pk2(y.z, y.w) << 32); }
    }
}

__device__ __forceinline__ void load_row64(const bf16* p, float (&f)[64]) {
    const GAS v4u* q = (const GAS v4u*)p;
#pragma unroll
    for (int i = 0; i < 8; ++i) { const v4u w = q[i];
        f[8 * i + 0] = bf_lo(w.x); f[8 * i + 1] = bf_hi(w.x); f[8 * i + 2] = bf_lo(w.y); f[8 * i + 3] = bf_hi(w.y);
        f[8 * i + 4] = bf_lo(w.z); f[8 * i + 5] = bf_hi(w.z); f[8 * i + 6] = bf_lo(w.w); f[8 * i + 7] = bf_hi(w.w); }
}
__device__ __forceinline__ void attn_key(const float (&q)[64], const bf16* kp, const bf16* vp, float bias, float (&o)[64], float& m, float& l) {
    float s0 = 0.f, s1 = 0.f;
    { const GAS v4u* kq = (const GAS v4u*)kp;
#pragma unroll
      for (int i = 0; i < 8; ++i) { const v4u w = kq[i];
        s0 += q[8 * i + 0] * bf_lo(w.x); s1 += q[8 * i + 1] * bf_hi(w.x); s0 += q[8 * i + 2] * bf_lo(w.y); s1 += q[8 * i + 3] * bf_hi(w.y);
        s0 += q[8 * i + 4] * bf_lo(w.z); s1 += q[8 * i + 5] * bf_hi(w.z); s0 += q[8 * i + 6] * bf_lo(w.w); s1 += q[8 * i + 7] * bf_hi(w.w); } }
    const float s = (s0 + s1) + bias;
    if (s > m) { const float f = __builtin_amdgcn_exp2f(m - s); l *= f;
#pragma unroll
        for (int i = 0; i < 64; ++i) o[i] *= f;
        m = s; }
    const float pp = __builtin_amdgcn_exp2f(s - m); l += pp;
    { const GAS v4u* vq = (const GAS v4u*)vp;
#pragma unroll
      for (int i = 0; i < 8; ++i) { const v4u w = vq[i];
        o[8 * i + 0] += pp * bf_lo(w.x); o[8 * i + 1] += pp * bf_hi(w.x); o[8 * i + 2] += pp * bf_lo(w.y); o[8 * i + 3] += pp * bf_hi(w.y);
        o[8 * i + 4] += pp * bf_lo(w.z); o[8 * i + 5] += pp * bf_hi(w.z); o[8 * i + 6] += pp * bf_lo(w.w); o[8 * i + 7] += pp * bf_hi(w.w); } }
}
__device__ __forceinline__ void naive_attn_phase(int kind, const bf16* QKV, int pitch, const float* sinks, const unsigned* mask32, bf16* O, int gw, int NGW, int lane) {
    OPAQUE_V(lane); OPAQUE_S(gw);
    for (int task = gw; task < BATCH * 64 * NH; task += NGW) {
        const int h = task & 31, tb = (task >> 5) & 63, b = task >> 11;
        const int t = tb * 64 + lane; const size_t row = (size_t)b * SEQ + t; const int kvh = h >> 3;
        const float slope = exp2f(-0.25f * (float)(h + 1)) * LOG2E;
        float o[64];
#pragma unroll
        for (int i = 0; i < 64; ++i) o[i] = 0.f;
        float m = -INFINITY, l = 0.f;
        if (kind == 0) { m = sinks[h] * LOG2E; l = 1.f; }
        const int ng = (kind == 1) ? 3 : 1;
        for (int g = 0; g < ng; ++g) {
            float q[64]; load_row64(QKV + row * pitch + g * A_IN + h * HD, q);
            const bf16* kbase = QKV + (size_t)b * SEQ * pitch + g * A_IN + QD + kvh * HD;
            if (kind != 2) {
                const int d = (g == 0) ? 1 : (g == 1 ? 4 : 16); const int W = (kind == 0) ? 128 : 129;
                for (int j = 0; j < W; ++j) { const int pos = t - j * d;
                    if (pos >= 0) { const bf16* kp = kbase + (size_t)pos * pitch; attn_key(q, kp, kp + KVD, -slope * (float)(j * d), o, m, l); } }
            } else {
                const unsigned* mr = mask32 + row * 128;
                for (int w = 0; w <= (t >> 5); ++w) { unsigned bits = mr[w];
                    while (bits) { const int i = __builtin_ctz(bits); bits &= bits - 1u; const int pos = 32 * w + i;
                        const bf16* kp = kbase + (size_t)pos * pitch; attn_key(q, kp, kp + KVD, -slope * (float)(t - pos), o, m, l); } }
            }
        }
        const float rl = 1.f / l; GAS v4u* op = (GAS v4u*)(O + row * QD + h * HD);
#pragma unroll
        for (int i = 0; i < 8; ++i) { v4u w; w.x = pk2(o[8 * i] * rl, o[8 * i + 1] * rl); w.y = pk2(o[8 * i + 2] * rl, o[8 * i + 3] * rl);
            w.z = pk2(o[8 * i + 4] * rl, o[8 * i + 5] * rl); w.w = pk2(o[8 * i + 6] * rl, o[8 * i + 7] * rl); op[i] = w; }
    }
}

__device__ __forceinline__ void naive_score_phase(const bf16* P, float* SC, LAS unsigned char* lds, int gw, int NGW, int wave, int lane) {
    OPAQUE_V(lane); OPAQUE_S(gw); OPAQUE_S(wave);
    LAS float* qs = (LAS float*)(lds + wave * 8192);
    LAS float* wsc = qs + IDXH * IDXD;
    for (int it = gw; it < 2 * SEQ; it += NGW) {
        const int i = it / (SEQ / 2), w = it % (SEQ / 2);
        const int base = (i >> 1) * SEQ; const int t = (i & 1) ? (SEQ - 1 - w) : w;
        const size_t row = (size_t)base + t;
        { const GAS v4u* qp = (const GAS v4u*)(P + row * C_INP + C_QI) + 2 * lane;
          const v4u a = qp[0], c = qp[1]; LAS float* d = qs + 16 * lane;
          d[0] = bf_lo(a.x); d[1] = bf_hi(a.x); d[2] = bf_lo(a.y); d[3] = bf_hi(a.y); d[4] = bf_lo(a.z); d[5] = bf_hi(a.z); d[6] = bf_lo(a.w); d[7] = bf_hi(a.w);
          d[8] = bf_lo(c.x); d[9] = bf_hi(c.x); d[10] = bf_lo(c.y); d[11] = bf_hi(c.y); d[12] = bf_lo(c.z); d[13] = bf_hi(c.z); d[14] = bf_lo(c.w); d[15] = bf_hi(c.w);
          if (lane < IDXH) { const unsigned short wv = *(const GAS unsigned short*)(P + row * C_INP + C_WI + lane); wsc[lane] = __uint_as_float((unsigned)wv << 16) * (0.25f * 0.125f); } }
        LDS_WAIT(); asm volatile("" ::: "memory");
        for (int kb = 0; kb <= (t >> 6); ++kb) {
            const int s = kb * 64 + lane; float kf[64]; load_row64(P + ((size_t)base + s) * C_INP + C_KI, kf);
            float sc = 0.f;
            for (int h = 0; h < IDXH; ++h) { float a0 = 0.f, a1 = 0.f;
#pragma unroll
                for (int d = 0; d < 64; d += 2) { a0 += qs[h * 64 + d] * kf[d]; a1 += qs[h * 64 + d + 1] * kf[d + 1]; }
                sc += wsc[h] * fmaxf(a0 + a1, 0.f); }
            SC[row * SEQ + s] = sc;
        }
        LDS_WAIT(); asm volatile("" ::: "memory");
    }
}

__device__ __forceinline__ unsigned fkey(float f) { const unsigned u = __float_as_uint(f); return (u & 0x80000000u) ? ~u : (u | 0x80000000u); }
__device__ __forceinline__ void select_phase(const float* SC, u64* MASK, int gw, int NGW, int lane) {
    OPAQUE_V(lane); OPAQUE_S(gw);
    for (int row = gw; row < MTOK; row += NGW) {
        const int t = row & (SEQ - 1); const int nblk = (t >> 6) + 1;
        const float* sr = SC + (size_t)row * SEQ;
        u64* mrow = MASK + (size_t)row * 64;
        if (t < TOPK) {
            for (int i = 0; i < nblk; ++i) { const u64 bits = __ballot(64 * i + lane <= t); if (lane == 0) mrow[i] = bits; }
            continue;
        }
        unsigned u[64];
#pragma unroll
        for (int i = 0; i < 64; ++i) { const int e = 64 * i + lane; u[i] = 0u; if (i < nblk) { if (e <= t) u[i] = fkey(sr[e]); } }
        unsigned T = 0u;
        for (int bit = 31; bit >= 0; --bit) {
            const unsigned cand = T | (1u << bit); unsigned c = 0u;
#pragma unroll
            for (int i = 0; i < 64; ++i) c += (u[i] >= cand) ? 1u : 0u;
            c = wave_sum_u(c);
            if (c >= (unsigned)TOPK) T = cand;
        }
        unsigned cg = 0u;
#pragma unroll
        for (int i = 0; i < 64; ++i) cg += (u[i] > T) ? 1u : 0u;
        cg = wave_sum_u(cg);
        const unsigned need = (unsigned)TOPK - cg; unsigned run = 0u;
        const u64 ltmask = (lane == 0) ? 0ull : (~0ull >> (64 - lane));
#pragma unroll
        for (int i = 0; i < 64; ++i) {
            if (i < nblk) {
                const bool gt = u[i] > T, eq = u[i] == T; const u64 eqm = __ballot(eq);
                const unsigned rank = run + (unsigned)__popcll(eqm & ltmask);
                const u64 bits = __ballot(gt || (eq && rank < need)); run += (unsigned)__popcll(eqm);
                if (lane == 0) mrow[i] = bits;
            }
        }
    }
}


namespace att {
typedef short bf16x8 __attribute__((ext_vector_type(8)));
typedef float f32x16 __attribute__((ext_vector_type(16)));
typedef short s16x4 __attribute__((ext_vector_type(4)));
typedef short v4i16_t __attribute__((ext_vector_type(4)));
#define ATT_CR(r) (((r) & 3) + 8 * ((r) >> 2))
constexpr float NEG_BIG = -1.0e30f;
constexpr int BUFB = 16384;

__device__ __forceinline__ s16x4 vtr(const LAS unsigned char* p) { return __builtin_bit_cast(s16x4, __builtin_amdgcn_ds_read_tr16_b64_v4i16((LAS v4i16_t*)p)); }
__device__ __forceinline__ float xhalf_max(float v) { auto rr = __builtin_amdgcn_permlane32_swap(__float_as_uint(v), __float_as_uint(v), false, false); return fmaxf(__uint_as_float(rr[0]), __uint_as_float(rr[1])); }
__device__ __forceinline__ float xhalf_sum(float v) { auto rr = __builtin_amdgcn_permlane32_swap(__float_as_uint(v), __float_as_uint(v), false, false); return __uint_as_float(rr[0]) + __uint_as_float(rr[1]); }
__device__ __forceinline__ unsigned cvtpk(float lo, float hi) { typedef float f2 __attribute__((ext_vector_type(2))); typedef __bf16 b2 __attribute__((ext_vector_type(2))); f2 v = {lo, hi}; b2 b = __builtin_convertvector(v, b2); return __builtin_bit_cast(unsigned, b); }

__device__ __forceinline__ void attn_phase(int kind, const bf16* P, int pitch, const float* sinks, const u64* MASK, bf16* Oout, LAS unsigned char* lds, int G) {
    int tid = threadIdx.x; OPAQUE_V(tid);
    const int lane = tid & 63, wave = __builtin_amdgcn_readfirstlane(tid >> 6), l31 = lane & 31, hi = lane >> 5;
    int koff[4];
#pragma unroll
    for (int s = 0; s < 4; ++s) koff[s] = l31 * 128 + (((2 * s + hi) ^ ((l31 >> 1) & 7)) << 4);
    const int q4 = (lane & 15) >> 2, g1 = (lane >> 4) & 1, p4 = lane & 3, fV = (q4 >> 1) & 1;
    int voff[2];
#pragma unroll
    for (int db = 0; db < 2; ++db) voff[db] = 8192 + (4 * hi + q4) * 128 + ((((db ^ fV) << 2) + 2 * g1 + (p4 >> 1)) << 4) + 8 * (p4 & 1);
    const int srow = tid >> 3, spc = tid & 7;
    const int skoff = srow * 128 + ((spc ^ ((srow >> 1) & 7)) << 4);
    const int svoff = 8192 + srow * 128 + ((spc ^ (((srow >> 1) & 1) << 2)) << 4);
    const bool useMask = (kind == 2);
    const int ng = (kind == 1) ? 3 : 1;

    for (int it = 0;; ++it) {
        const int v = it * G + (int)blockIdx.x; if (v >= 1024) break;
        const int combo = v & 7, qq = v >> 3, jq = qq & 31, kq = qq >> 5;
        const int tile = (kq == 0) ? jq : (kq == 1) ? 63 - jq : (kq == 2) ? 64 + jq : 127 - jq;
        const int b = combo >> 2, kvh = combo & 3, h = kvh * 8 + wave;
        const float slope = exp2f(-0.25f * (float)(h + 1)) * LOG2E;
        const int T0 = (kind == 1) ? (512 * (tile >> 4) + (tile & 15)) : 32 * tile;
        const int qstride = (kind == 1) ? 16 : 1;
        const size_t brow = (size_t)b * SEQ;
        const size_t qrow = brow + T0 + l31 * qstride;
        f32x16 O0, O1;
#pragma unroll
        for (int r = 0; r < 16; ++r) { O0[r] = 0.f; O1[r] = 0.f; }
        float m = NEG_BIG, lsum = 0.f;
        if (kind == 0) { m = sinks[h] * LOG2E; lsum = (hi == 0) ? 1.f : 0.f; }

        for (int g = 0; g < ng; ++g) {
            const int dsh = (kind == 1) ? 2 * g : 0, d = 1 << dsh;
            const int W = (kind == 0) ? 128 : (kind == 1) ? 129 : (1 << 20);
            const int qs = qstride >> dsh;
            const int cbase = g * A_IN;
            const int res = T0 & (d - 1), u0 = T0 >> dsh;
            const int uq = u0 + l31 * qs, khi = u0 + 31 * qs;
            int klo = u0 - (W - 1); klo = (klo < 0 ? 0 : klo) & ~31;
            const int nsub = ((khi - klo) >> 5) + 1, nch = (nsub + 1) >> 1;
            const float c1 = slope * (float)d;
            bf16x8 qf[4];
#pragma unroll
            for (int s = 0; s < 4; ++s) qf[s] = *(const GAS bf16x8*)(P + qrow * pitch + cbase + h * HD + 16 * s + 8 * hi);
            const bf16* kcol = P + cbase + QD + kvh * HD + spc * 8;
            v4u kreg, vreg; u64 mw = 0ull, mwn = 0ull;
            { int tok = (klo + srow) * d + res; tok = tok > SEQ - 1 ? SEQ - 1 : tok; const bf16* kp = kcol + (brow + tok) * pitch;
              kreg = *(const GAS v4u*)kp; vreg = *(const GAS v4u*)(kp + KVD);
              if (useMask) mw = MASK[qrow * 64 + (klo >> 6)]; }
            *(LAS v4u*)(lds + skoff) = kreg; *(LAS v4u*)(lds + svoff) = vreg;
            __syncthreads();
            for (int c = 0; c < nch; ++c) {
                const int kidxc = klo + 64 * c; const int bufo = (c & 1) * BUFB;
                if (c + 1 < nch) { int tok = (kidxc + 64 + srow) * d + res; tok = tok > SEQ - 1 ? SEQ - 1 : tok; const bf16* kp = kcol + (brow + tok) * pitch;
                    kreg = *(const GAS v4u*)kp; vreg = *(const GAS v4u*)(kp + KVD);
                    if (useMask) mwn = MASK[qrow * 64 + ((kidxc + 64) >> 6)]; }
#pragma unroll
                for (int sub = 0; sub < 2; ++sub) {
                    if (2 * c + sub < nsub) {
                        const int kidx0 = kidxc + 32 * sub;
                        const int dq = uq - kidx0 - 4 * hi;
                        const float base = c1 * (float)(-dq);
                        f32x16 S;
#pragma unroll
                        for (int r = 0; r < 16; ++r) S[r] = fmaf((float)ATT_CR(r), c1, base);
                        const LAS unsigned char* kb = lds + bufo + sub * 4096;
#pragma unroll
                        for (int s = 0; s < 4; ++s) { const bf16x8 kf = *(const LAS bf16x8*)(kb + koff[s]); S = __builtin_amdgcn_mfma_f32_32x32x16_bf16(kf, qf[s], S, 0, 0, 0); }
                        const bool full = (u0 - (kidx0 + 31) >= 0) && (khi - kidx0 <= W - 1);
                        if (!full) {
#pragma unroll
                            for (int r = 0; r < 16; ++r) { const int dist = dq - ATT_CR(r); if ((unsigned)dist >= (unsigned)W) S[r] = NEG_BIG; }
                        }
                        if (useMask) { const unsigned mws = (unsigned)(mw >> (32 * sub)) >> (4 * hi);
#pragma unroll
                            for (int r = 0; r < 16; ++r) { if (((mws >> ATT_CR(r)) & 1u) == 0u) S[r] = NEG_BIG; }
                        }
                        float mloc = fmaxf(fmaxf(S[0], S[1]), fmaxf(S[2], S[3]));
#pragma unroll
                        for (int r = 4; r < 16; r += 4) mloc = fmaxf(mloc, fmaxf(fmaxf(S[r], S[r + 1]), fmaxf(S[r + 2], S[r + 3])));
                        const float mnew = fmaxf(m, xhalf_max(mloc));
                        if (__any(mnew > m)) { const float al = __builtin_amdgcn_exp2f(m - mnew); lsum *= al;
#pragma unroll
                            for (int r = 0; r < 16; ++r) { O0[r] *= al; O1[r] *= al; }
                            m = mnew; }
                        float ps = 0.f;
#pragma unroll
                        for (int r = 0; r < 16; ++r) { S[r] = __builtin_amdgcn_exp2f(S[r] - m); ps += S[r]; }
                        lsum += ps;
                        v4u pa, pb;
                        pa.x = cvtpk(S[0], S[1]); pa.y = cvtpk(S[2], S[3]); pa.z = cvtpk(S[4], S[5]); pa.w = cvtpk(S[6], S[7]);
                        pb.x = cvtpk(S[8], S[9]); pb.y = cvtpk(S[10], S[11]); pb.z = cvtpk(S[12], S[13]); pb.w = cvtpk(S[14], S[15]);
                        const bf16x8 P0 = __builtin_bit_cast(bf16x8, pa), P1 = __builtin_bit_cast(bf16x8, pb);
                        const LAS unsigned char* vb = lds + bufo + sub * 4096;
#pragma unroll
                        for (int s = 0; s < 2; ++s) {
                            const s16x4 a0l = vtr(vb + voff[0] + s * 2048), a0h = vtr(vb + voff[0] + s * 2048 + 1024);
                            const s16x4 a1l = vtr(vb + voff[1] + s * 2048), a1h = vtr(vb + voff[1] + s * 2048 + 1024);
                            const bf16x8 A0 = (bf16x8){a0l[0], a0l[1], a0l[2], a0l[3], a0h[0], a0h[1], a0h[2], a0h[3]};
                            const bf16x8 A1 = (bf16x8){a1l[0], a1l[1], a1l[2], a1l[3], a1h[0], a1h[1], a1h[2], a1h[3]};
                            O0 = __builtin_amdgcn_mfma_f32_32x32x16_bf16(A0, s == 0 ? P0 : P1, O0, 0, 0, 0);
                            O1 = __builtin_amdgcn_mfma_f32_32x32x16_bf16(A1, s == 0 ? P0 : P1, O1, 0, 0, 0);
                        }
                    }
                }
                if (c + 1 < nch) { const int bo = ((c + 1) & 1) * BUFB; *(LAS v4u*)(lds + bo + skoff) = kreg; *(LAS v4u*)(lds + bo + svoff) = vreg; mw = mwn; }
                __syncthreads();
            }
        }
        const float rl = 1.0f / xhalf_sum(lsum);
        bf16* op = Oout + qrow * QD + h * HD + 4 * hi;
#pragma unroll
        for (int rq = 0; rq < 4; ++rq) {
            const u64 w0 = (u64)cvtpk(O0[4 * rq] * rl, O0[4 * rq + 1] * rl) | ((u64)cvtpk(O0[4 * rq + 2] * rl, O0[4 * rq + 3] * rl) << 32);
            const u64 w1 = (u64)cvtpk(O1[4 * rq] * rl, O1[4 * rq + 1] * rl) | ((u64)cvtpk(O1[4 * rq + 2] * rl, O1[4 * rq + 3] * rl) << 32);
            *(GAS u64*)(op + 8 * rq) = w0; *(GAS u64*)(op + 32 + 8 * rq) = w1;
        }
    }
}
}

namespace att {
__device__ __forceinline__ void score_phase(const bf16* P, float* SC, LAS unsigned char* lds, int G) {
    int tid = threadIdx.x; OPAQUE_V(tid);
    const int lane = tid & 63, wave = __builtin_amdgcn_readfirstlane(tid >> 6), l31 = lane & 31, hi = lane >> 5;
    int koff[4];
#pragma unroll
    for (int s = 0; s < 4; ++s) koff[s] = l31 * 128 + (((2 * s + hi) ^ ((l31 >> 1) & 7)) << 4);
    const int srow = tid >> 3, spc = tid & 7;
    const int skoff = srow * 128 + ((spc ^ ((srow >> 1) & 7)) << 4);
    for (int it = 0;; ++it) {
        const int v = it * G + (int)blockIdx.x; if (v >= 512) break;
        const int b = v & 1, q = v >> 1, tile = (q < 128) ? q : 383 - q;
        const int t0 = 16 * tile; const size_t brow = (size_t)b * SEQ;
        const int tl = l31 >> 4, hh = l31 & 15;
        const size_t arow = brow + t0 + 2 * wave + tl;
        bf16x8 qa[4];
#pragma unroll
        for (int s = 0; s < 4; ++s) qa[s] = *(const GAS bf16x8*)(P + arow * C_INP + C_QI + hh * IDXD + 16 * s + 8 * hi);
        float wv[2][8];
#pragma unroll
        for (int t2 = 0; t2 < 2; ++t2)
#pragma unroll
            for (int part = 0; part < 2; ++part) { const u64 w4 = *(const GAS u64*)(P + (brow + t0 + 2 * wave + t2) * C_INP + C_WI + 8 * part + 4 * hi);
                wv[t2][4 * part + 0] = bf_lo((unsigned)w4) * 0.03125f; wv[t2][4 * part + 1] = bf_hi((unsigned)w4) * 0.03125f;
                wv[t2][4 * part + 2] = bf_lo((unsigned)(w4 >> 32)) * 0.03125f; wv[t2][4 * part + 3] = bf_hi((unsigned)(w4 >> 32)) * 0.03125f; }
        const int nsub = ((t0 + 15) >> 5) + 1, nch = (nsub + 1) >> 1;
        const bf16* kcol = P + C_KI + spc * 8;
        v4u kreg;
        { int tok = srow; kreg = *(const GAS v4u*)(kcol + (brow + tok) * C_INP); }
        *(LAS v4u*)(lds + skoff) = kreg;
        __syncthreads();
        float* orow = SC + (brow + t0 + 2 * wave + hi) * SEQ + l31;
        for (int c = 0; c < nch; ++c) {
            const int bufo = (c & 1) * BUFB;
            if (c + 1 < nch) { int tok = 64 * (c + 1) + srow; tok = tok > SEQ - 1 ? SEQ - 1 : tok; kreg = *(const GAS v4u*)(kcol + (brow + tok) * C_INP); }
#pragma unroll
            for (int sub = 0; sub < 2; ++sub) {
                if (2 * c + sub < nsub) {
                    f32x16 S;
#pragma unroll
                    for (int r = 0; r < 16; ++r) S[r] = 0.f;
                    const LAS unsigned char* kb = lds + bufo + sub * 4096;
#pragma unroll
                    for (int s = 0; s < 4; ++s) { const bf16x8 kf = *(const LAS bf16x8*)(kb + koff[s]); S = __builtin_amdgcn_mfma_f32_32x32x16_bf16(qa[s], kf, S, 0, 0, 0); }
                    float p0 = 0.f, p1 = 0.f;
#pragma unroll
                    for (int r = 0; r < 8; ++r) { p0 = fmaf(wv[0][r], fmaxf(S[r], 0.f), p0); p1 = fmaf(wv[1][r], fmaxf(S[r + 8], 0.f), p1); }
                    const float x0 = xhalf_sum(p0), x1 = xhalf_sum(p1);
                    orow[64 * c + 32 * sub] = hi ? x1 : x0;
                }
            }
            if (c + 1 < nch) { *(LAS v4u*)(lds + ((c + 1) & 1) * BUFB + skoff) = kreg; }
            __syncthreads();
        }
    }
}
}

#ifndef NEW_ATTN_KINDS
#define NEW_ATTN_KINDS 7
#endif
constexpr int NPH = 1 + 9 * DEPTH;
__host__ __device__ inline bool phase_exists(int k) { if (k == 0) return true; const int l = (k - 1) / 9, j = (k - 1) % 9; return (j == 1 || j == 2) ? (l % 3 == 2) : true; }

__global__ void __launch_bounds__(NWAVES * 64, 2) fwd_kernel(Params p) {
    extern __shared__ __attribute__((aligned(16))) unsigned char lds_raw[];
    LAS unsigned char* lds = (LAS unsigned char*)lds_raw;
    volatile LAS unsigned* MISC = (volatile LAS unsigned*)(lds + MISC_OFF);
    const int tid = threadIdx.x, lane = tid & 63, wave = __builtin_amdgcn_readfirstlane(tid >> 6);
    const int G = gridDim.x; const int gw = blockIdx.x * NWAVES + wave, NGW = G * NWAVES;
    unsigned char* ws = p.ws;
    gu32* ctl = (gu32*)(ws + WS_CTL);
    for (int u = tid; u < (LDS_BYTES - LDSCTL_OFF) / 4; u += NWAVES * 64) ((LAS unsigned*)(lds + LDSCTL_OFF))[u] = 0u;
    __syncthreads();
    const int lo = p.ph_lo, hi = p.ph_hi;
    XcdBarrier bar; bar.bar = (unsigned*)(ctl + CW_BAR) + p.li * XCD_BAR_WORDS; bar.x = 0; bar.st = nullptr;
    if (hi - lo > 1) bar = xcd_barrier_post((unsigned*)(ctl + CW_BAR) + p.li * XCD_BAR_WORDS, MISC + 8);
#define IN(k) (lo <= (k) && (k) < hi)
#define SEAM(k) do { if ((k) + 1 < hi) xcd_barrier(bar); } while (0)

    bf16* XB = (bf16*)(ws + WS_XB); float* X = (float*)(ws + WS_X); float* Z = (float*)(ws + WS_Z); bf16* O = (bf16*)(ws + WS_O);
    bf16* QKV = (bf16*)(ws + WS_QKV); bf16* H = (bf16*)(ws + WS_H); float* SC = (float*)(ws + WS_SC); u64* MASK = (u64*)(ws + WS_MASK);

    if (IN(0)) { prologue_phase(p, lds, gw, NGW, wave, lane); SEAM(0); }

    for (int l = 0; l < DEPTH; ++l) {
        const int kind = l % 3, jj = l / 3, pb = 1 + 9 * l;
        const bf16* Win; const bf16* Wout; int Nin;
        if (kind == 0)      { Win = (const bf16*)(ws + WS_W_AIN) + (size_t)jj * A_IN * DM; Wout = (const bf16*)(ws + WS_W_AOUT) + (size_t)jj * DM * QD; Nin = A_IN; }
        else if (kind == 1) { Win = (const bf16*)(ws + WS_W_BIN); Wout = (const bf16*)(ws + WS_W_BOUT); Nin = B_IN; }
        else                { Win = (const bf16*)(ws + WS_W_CIN); Wout = (const bf16*)(ws + WS_W_COUT); Nin = C_INP; }
        const float* xbase = (l == 0) ? p.x : X;

        if (IN(pb + 0)) {
            pg8::Gemm g{XB, Win, MTOK, Nin, DM}; pg8::StaticOrder S; S.init(MTOK, Nin, G, (int)blockIdx.x);
            pg8::EpiQKV E{QKV, Nin, (kind == 2) ? C_INP : A_IN, QD, C2};
            pg8::gemm_phase<pg8::EpiQKV, pg8::StaticOrder, true, true>(lds, g, S, E);
            SEAM(pb + 0);
        }
        if (kind == 2 && IN(pb + 1)) { att::score_phase(QKV, SC, lds, G); SEAM(pb + 1); }
        if (kind == 2 && IN(pb + 2)) { select_phase(SC, MASK, gw, NGW, lane); SEAM(pb + 2); }
        if (IN(pb + 3)) {
            if ((NEW_ATTN_KINDS >> kind) & 1) att::attn_phase(kind, QKV, Nin, p.a_sinks + jj * NH, MASK, O, lds, G);
            else naive_attn_phase(kind, QKV, Nin, p.a_sinks + jj * NH, (const unsigned*)MASK, O, gw, NGW, lane);
            SEAM(pb + 3);
        }
        if (IN(pb + 4)) {
            pg8::Gemm g{O, Wout, MTOK, DM, QD}; pg8::StaticOrder S; S.init(MTOK, DM, G, (int)blockIdx.x);
            pg8::EpiResid E{xbase, Z, DM, ALPHA};
            pg8::gemm_phase<pg8::EpiResid, pg8::StaticOrder, true, true>(lds, g, S, E);
            SEAM(pb + 4);
        }
        if (IN(pb + 5)) { ln_phase(Z, p.ln_g + (size_t)(2 * l) * DM, p.ln_b + (size_t)(2 * l) * DM, X, XB, gw, NGW, lane); SEAM(pb + 5); }
        if (IN(pb + 6)) {
            pg8::Gemm g{XB, (const bf16*)(ws + WS_W_GU) + (size_t)l * NGU * DM, MTOK, NGU, DM}; pg8::StaticOrder S; S.init(MTOK, NGU, G, (int)blockIdx.x);
            pg8::EpiSwiGLU E{H, DFF};
            pg8::gemm_phase<pg8::EpiSwiGLU, pg8::StaticOrder, true, true>(lds, g, S, E);
            SEAM(pb + 6);
        }
        if (IN(pb + 7)) {
            pg8::Gemm g{H, (const bf16*)(ws + WS_W_DN) + (size_t)l * DM * DFF, MTOK, DM, DFF}; pg8::StaticOrder S; S.init(MTOK, DM, G, (int)blockIdx.x);
            pg8::EpiResid E{X, Z, DM, ALPHA};
            pg8::gemm_phase<pg8::EpiResid, pg8::StaticOrder, true, true>(lds, g, S, E);
            SEAM(pb + 7);
        }
        if (IN(pb + 8)) { ln_phase(Z, p.ln_g + (size_t)(2 * l + 1) * DM, p.ln_b + (size_t)(2 * l + 1) * DM, (l == DEPTH - 1) ? p.out : X, XB, gw, NGW, lane); SEAM(pb + 8); }
    }
#undef IN
#undef SEAM
}

#ifndef MK_PER_PHASE
#define MK_PER_PHASE 0
#endif
extern "C" void kernel_launch(void* const* d_in, const int* in_sizes, int n_in, void* d_out, int out_size, void* d_ws, size_t ws_size, hipStream_t stream) {
    static int grid = 0;
    if (grid == 0) {
        if (n_in != 12 || in_sizes[0] != MTOK * DM || out_size != MTOK * DM || ws_size < WS_END) {
            fprintf(stderr, "kernel_launch: unexpected shapes (n_in %d, in0 %d, out %d, ws %zu < %zu?); nothing launched\n", n_in, n_in > 0 ? in_sizes[0] : -1, out_size, ws_size, (size_t)WS_END); grid = -1; return; }
        int dev = 0, cus = 0, per_cu = 0;
        if (hipGetDevice(&dev) != hipSuccess || hipDeviceGetAttribute(&cus, hipDeviceAttributeMultiprocessorCount, dev) != hipSuccess) { grid = -1; return; }
        if (hipFuncSetAttribute((const void*)fwd_kernel, hipFuncAttributeMaxDynamicSharedMemorySize, LDS_BYTES) != hipSuccess) { fprintf(stderr, "kernel_launch: hipFuncSetAttribute failed\n"); grid = -1; return; }
        if (hipOccupancyMaxActiveBlocksPerMultiprocessor(&per_cu, (const void*)fwd_kernel, NWAVES * 64, LDS_BYTES) != hipSuccess || per_cu < 1)
            fprintf(stderr, "kernel_launch: note: occupancy query reports %d workgroups per CU\n", per_cu);
        (void)hipGetLastError();
        grid = cus;
    }
    if (grid < 0) return;
    if (hipMemsetAsync((char*)d_ws + WS_CTL, 0, CTL_ZERO_BYTES, stream) != hipSuccess) { fprintf(stderr, "kernel_launch: hipMemsetAsync failed\n"); return; }
    Params a{};
    a.x = (const float*)d_in[0]; a.a_w_in = (const float*)d_in[1]; a.a_sinks = (const float*)d_in[2]; a.a_w_out = (const float*)d_in[3];
    a.b_w_in = (const float*)d_in[4]; a.b_w_out = (const float*)d_in[5]; a.c_w_in = (const float*)d_in[6]; a.c_w_out = (const float*)d_in[7];
    a.ln_g = (const float*)d_in[8]; a.ln_b = (const float*)d_in[9]; a.w_gu = (const float*)d_in[10]; a.w_dn = (const float*)d_in[11];
    a.out = (float*)d_out; a.ws = (unsigned char*)d_ws; a.pad = 0;
#if MK_PER_PHASE
    int li = 0;
    for (int k = 0; k < NPH; ++k) { if (!phase_exists(k)) continue; a.ph_lo = k; a.ph_hi = k + 1; a.li = li++;
        hipLaunchKernelGGL(fwd_kernel, dim3(grid), dim3(NWAVES * 64), LDS_BYTES, stream, a); }
#else
    a.ph_lo = 0; a.ph_hi = NPH; a.li = 0;
    hipLaunchKernelGGL(fwd_kernel, dim3(grid), dim3(NWAVES * 64), LDS_BYTES, stream, a);
#endif
    const hipError_t le = hipPeekAtLastError();
    if (le != hipSuccess) fprintf(stderr, "kernel_launch: launch failed: %s\n", hipGetErrorName(le));
}
```

```cpp
#include <hip/hip_runtime.h>
#include <cstdio>
#include <cstdint>
namespace pg8 {
#define PG8_LAS __attribute__((address_space(3)))
typedef unsigned short bf16_t;
typedef short bf16x8 __attribute__((ext_vector_type(8)));
typedef float f32x4 __attribute__((ext_vector_type(4)));
typedef unsigned u32x4 __attribute__((ext_vector_type(4)));
constexpr int BM = 256, BK = 64, HALF = 128, HTB = HALF * BK * 2  , STAGE_BYTES = 8 * HTB, NXCD = 8, WGM = 8;

__host__ __device__ __forceinline__ int lds_byte(int r, int c) { const int st = (r >> 4) * 2 + (c >> 5), rr = r & 15, cc = c & 31, ob = rr * 64 + cc * 2; return st * 1024 + (ob ^ (((ob >> 9) & 1) << 5)); }
__host__ __device__ __forceinline__ void stage_rc(int b, int& R, int& C) { const int st = b / 1024, sb = b % 1024, swz = sb ^ (((sb >> 9) & 1) << 5); R = (st >> 1) * 16 + swz / 64; C = (st & 1) * 32 + (swz % 64) / 2; }
__host__ __device__ __forceinline__ int perm32(int rho) { const int n = rho >> 4, i = rho & 15; return 8 * (i >> 2) + 4 * n + (i & 3); }

struct Unit { int pm, pn; };
struct Gemm { const bf16_t* A; const bf16_t* Bt; int M, N, K; };

struct StaticOrder {
    int nM, nN, nwg, G, c;
    __host__ __device__ void init(int M, int N, int G_, int c_) { nM = M / BM; nN = N / BM; nwg = nM * nN; G = G_; c = c_; }
    __host__ __device__ bool next(int i, Unit& u) const {
        const long L = (long)i * G + c; if (L >= nwg) return false;
        int wgid = (int)L; { const int q = nwg / NXCD, r = nwg % NXCD, xcd = wgid % NXCD, off = wgid / NXCD; wgid = (xcd < r ? xcd * (q + 1) : r * (q + 1) + (xcd - r) * q) + off; }
        const int nig = WGM * nN, gid = wgid / nig, fm = gid * WGM, gsz = (nM - fm) < WGM ? (nM - fm) : WGM;
        u.pm = fm + ((wgid % nig) % gsz); u.pn = (wgid % nig) / gsz; return true;
    }
    __device__ __forceinline__ void a_ready(const Unit&) const {}
    __device__ __forceinline__ void done(const Unit&) const {}
};


__device__ __forceinline__ unsigned cvt_pk_bf16(float lo, float hi) { unsigned r; asm volatile("v_cvt_pk_bf16_f32 %0, %1, %2" : "=v"(r) : "v"(lo), "v"(hi)); return r; }

struct EpiQKV {
    static constexpr bool PERM = true, AFTER_DRAIN = false;
    bf16_t* O; int ldc; int qmod, qlim; float qscale;
    __device__ __forceinline__ void operator()(const f32x4 (&acc)[2][2][4][2], const Unit& u, int wr, int wc, int fr, int fq) const {
        const int row0 = u.pm * BM + wr * 64 + fr; const int colt = u.pn * BM;
        const float sc = ((colt % qmod) < qlim) ? qscale : 1.f;
        const int col0 = colt + wc * 32 + 8 * fq;
#pragma unroll
        for (int ai = 0; ai < 2; ++ai)
#pragma unroll
            for (int m = 0; m < 4; ++m) { bf16_t* rowp = O + (size_t)(row0 + ai * HALF + m * 16) * ldc + col0;
#pragma unroll
                for (int bj = 0; bj < 2; ++bj) { f32x4 v0 = acc[ai][bj][m][0] * sc, v1 = acc[ai][bj][m][1] * sc;
                    u32x4 w; w.x = cvt_pk_bf16(v0[0], v0[1]); w.y = cvt_pk_bf16(v0[2], v0[3]); w.z = cvt_pk_bf16(v1[0], v1[1]); w.w = cvt_pk_bf16(v1[2], v1[3]);
                    *(u32x4*)(rowp + bj * HALF) = w; } }
    }
};
struct EpiSwiGLU {
    static constexpr bool PERM = true, AFTER_DRAIN = false;
    bf16_t* Hh; int ldc;
    __device__ __forceinline__ float sg(float g, float uu) const { const float e = __builtin_amdgcn_exp2f(g * -1.4426950408889634f); return g * __builtin_amdgcn_rcpf(1.0f + e) * uu; }
    __device__ __forceinline__ void operator()(const f32x4 (&acc)[2][2][4][2], const Unit& u, int wr, int wc, int fr, int fq) const {
        const int row0 = u.pm * BM + wr * 64 + fr; const int col0 = u.pn * HALF + wc * 32 + 8 * fq;
#pragma unroll
        for (int ai = 0; ai < 2; ++ai)
#pragma unroll
            for (int m = 0; m < 4; ++m) { bf16_t* rowp = Hh + (size_t)(row0 + ai * HALF + m * 16) * ldc + col0;
                const f32x4 g0 = acc[ai][0][m][0], g1 = acc[ai][0][m][1], u0 = acc[ai][1][m][0], u1 = acc[ai][1][m][1];
                u32x4 w; w.x = cvt_pk_bf16(sg(g0[0], u0[0]), sg(g0[1], u0[1])); w.y = cvt_pk_bf16(sg(g0[2], u0[2]), sg(g0[3], u0[3]));
                w.z = cvt_pk_bf16(sg(g1[0], u1[0]), sg(g1[1], u1[1])); w.w = cvt_pk_bf16(sg(g1[2], u1[2]), sg(g1[3], u1[3]));
                *(u32x4*)rowp = w; }
    }
};
struct EpiResid {
    static constexpr bool PERM = false, AFTER_DRAIN = false;
    const float* base; float* out; int ldc; float alpha;
    __device__ __forceinline__ void operator()(const f32x4 (&acc)[2][2][4][2], const Unit& u, int wr, int wc, int fr, int fq) const {
        const int row0 = u.pm * BM + wr * 64 + fr, col0 = u.pn * BM + wc * 32 + 4 * fq;
#pragma unroll
        for (int ai = 0; ai < 2; ++ai)
#pragma unroll
            for (int m = 0; m < 4; ++m) { const size_t off = (size_t)(row0 + ai * HALF + m * 16) * ldc + col0;
#pragma unroll
                for (int bj = 0; bj < 2; ++bj)
#pragma unroll
                    for (int n = 0; n < 2; ++n) { const f32x4 bs = *(const f32x4*)(base + off + bj * HALF + n * 16); *(f32x4*)(out + off + bj * HALF + n * 16) = bs * alpha + acc[ai][bj][m][n]; }
                asm volatile("" ::: "memory"); }
    }
};

template <class Epi, class Sched, bool ALIGN_EPI = false, bool SP2 = false>
__device__ __forceinline__ void gemm_phase(PG8_LAS unsigned char* lds, const Gemm g, const Sched& S, const Epi& E) {
    int tid_ = threadIdx.x; asm volatile("" : "+v"(tid_));
    const int tid = tid_, wid = __builtin_amdgcn_readfirstlane(tid >> 6), lane = tid & 63, wr = wid >> 2, wc = wid & 3, fr = lane & 15, fq = lane >> 4;
    const int K = g.K, nt = K / BK;
    unsigned voffA[2], voffB[2];
#pragma unroll
    for (int i = 0; i < 2; ++i) { int R, C; stage_rc(tid * 16 + i * 8192, R, C); const int Rb = Epi::PERM ? ((R & ~31) + perm32(R & 31)) : R;
        voffA[i] = (unsigned)(R * K + C) * 2u; voffB[i] = (unsigned)(Rb * K + C) * 2u; }
    const size_t kstep = (size_t)(BK * 2);
    const size_t hstep = (size_t)HALF * K * 2;
    const size_t tstep = 2 * hstep;
    const unsigned ldsw = (unsigned)wid * 1024u;
    const int aoff = lds_byte(wr * 64 + fr, fq * 8), boff = lds_byte(wc * 32 + fr, fq * 8);
#define PG8_SA(b, h) (((b) * 2 + (h)) * HTB)
#define PG8_SB(b, h) ((4 + (b) * 2 + (h)) * HTB)
#define PG8_STAGE(bufoff, gbase, voff) do { _Pragma("unroll") for (int _i = 0; _i < 2; ++_i) \
        __builtin_amdgcn_global_load_lds((const unsigned*)((const char*)(gbase) + (voff)[_i]), (PG8_LAS unsigned*)(lds + (bufoff) + ldsw + _i * 8192), 16, 0, 0); } while (0)
#define PG8_LDA(dst, b, h) do { _Pragma("unroll") for (int m = 0; m < 4; ++m) _Pragma("unroll") for (int k = 0; k < 2; ++k) dst[m][k] = *(const PG8_LAS bf16x8*)(lds + PG8_SA(b, h) + aoff + m * 2048 + k * 1024); } while (0)
#define PG8_LDB(dst, b, h) do { _Pragma("unroll") for (int n = 0; n < 2; ++n) _Pragma("unroll") for (int k = 0; k < 2; ++k) dst[n][k] = *(const PG8_LAS bf16x8*)(lds + PG8_SB(b, h) + boff + n * 2048 + k * 1024); } while (0)
#define PG8_MMA(ai, bj, At, Bt) do { __builtin_amdgcn_s_setprio(1); _Pragma("unroll") for (int m = 0; m < 4; ++m) _Pragma("unroll") for (int n = 0; n < 2; ++n) _Pragma("unroll") for (int k = 0; k < 2; ++k) \
        acc[ai][bj][m][n] = __builtin_amdgcn_mfma_f32_16x16x32_bf16(Bt[n][k], At[m][k], acc[ai][bj][m][n], 0, 0, 0); __builtin_amdgcn_s_setprio(0); } while (0)
#define PG8_WAIT_V(n) asm volatile("s_waitcnt vmcnt(" #n ")" ::: "memory")
#define PG8_WAIT_L(n) asm volatile("s_waitcnt lgkmcnt(" #n ")" ::: "memory")
#define PG8_BAR __builtin_amdgcn_s_barrier()
#define PG8_SCHED __builtin_amdgcn_sched_barrier(0)
    Unit cur, nxt; int ui = 0;
    if (!S.next(0, cur)) return;
    f32x4 acc[2][2][4][2];
#pragma unroll
    for (int a = 0; a < 2; ++a)
#pragma unroll
        for (int b = 0; b < 2; ++b)
#pragma unroll
            for (int m = 0; m < 4; ++m)
#pragma unroll
                for (int n = 0; n < 2; ++n) acc[a][b][m][n] = (f32x4){0.f, 0.f, 0.f, 0.f};
    bf16x8 At[4][2], B0[2][2], B1[2][2];
    const char* cA = (const char*)g.A + (size_t)cur.pm * tstep; const char* cB = (const char*)g.Bt + (size_t)cur.pn * tstep;
    S.a_ready(cur);
    if constexpr (SP2) {
        PG8_STAGE(PG8_SB(0, 0), cB, voffB); PG8_STAGE(PG8_SB(0, 1), cB + hstep, voffB); PG8_STAGE(PG8_SA(0, 0), cA, voffA); PG8_STAGE(PG8_SA(0, 1), cA + hstep, voffA);
        if (wr == 1) PG8_BAR;
        PG8_WAIT_V(2); PG8_BAR;
        PG8_STAGE(PG8_SB(1, 0), cB + kstep, voffB); PG8_STAGE(PG8_SA(1, 0), cA + kstep, voffA); PG8_STAGE(PG8_SB(1, 1), cB + hstep + kstep, voffB);
        PG8_WAIT_V(6); PG8_BAR;
    } else {
        PG8_STAGE(PG8_SB(0, 0), cB, voffB); PG8_STAGE(PG8_SA(0, 0), cA, voffA); PG8_STAGE(PG8_SB(0, 1), cB + hstep, voffB); PG8_STAGE(PG8_SA(0, 1), cA + hstep, voffA);
        if (wr == 1) PG8_BAR;
        PG8_WAIT_V(4); PG8_BAR;
        PG8_STAGE(PG8_SB(1, 0), cB + kstep, voffB); PG8_STAGE(PG8_SA(1, 0), cA + kstep, voffA); PG8_STAGE(PG8_SB(1, 1), cB + hstep + kstep, voffB);
        PG8_WAIT_V(6); PG8_BAR;
    }
    for (;;) {
        const bool has_next = S.next(ui + 1, nxt);
        const char* nA = has_next ? (const char*)g.A + (size_t)nxt.pm * tstep : cA; const char* nB = has_next ? (const char*)g.Bt + (size_t)nxt.pn * tstep : cB;
        for (int t = 0; t < nt; t += 2) {
            const bool last = (t == nt - 2);
            const char* a1 = cA + (size_t)(t + 1) * kstep;
            const char* a2 = last ? nA : cA + (size_t)(t + 2) * kstep; const char* b2 = last ? nB : cB + (size_t)(t + 2) * kstep;
            const char* a3 = a2 + kstep; const char* b3 = b2 + kstep;
            if (last && has_next) S.a_ready(nxt);
            if constexpr (SP2) {
            PG8_LDB(B0, 0, 0); PG8_LDB(B1, 0, 1); PG8_SCHED; PG8_LDA(At, 0, 0); PG8_STAGE(PG8_SA(1, 1), a1 + hstep, voffA);
            PG8_WAIT_V(8); PG8_WAIT_L(0); PG8_BAR; PG8_MMA(0, 0, At, B0); PG8_MMA(0, 1, At, B1); PG8_BAR; PG8_SCHED;
            PG8_LDA(At, 0, 1); PG8_STAGE(PG8_SB(0, 0), b2, voffB); PG8_STAGE(PG8_SB(0, 1), b2 + hstep, voffB); PG8_STAGE(PG8_SA(0, 0), a2, voffA);
            PG8_WAIT_V(8); PG8_WAIT_L(0); PG8_BAR; PG8_MMA(1, 0, At, B0); PG8_MMA(1, 1, At, B1); PG8_BAR; PG8_SCHED;
            PG8_LDB(B0, 1, 0); PG8_LDB(B1, 1, 1); PG8_SCHED; PG8_LDA(At, 1, 0); PG8_STAGE(PG8_SA(0, 1), a2 + hstep, voffA);
            PG8_WAIT_V(8); PG8_WAIT_L(0); PG8_BAR; PG8_MMA(0, 0, At, B0); PG8_MMA(0, 1, At, B1); PG8_BAR; PG8_SCHED;
            PG8_LDA(At, 1, 1); PG8_STAGE(PG8_SB(1, 0), b3, voffB); PG8_STAGE(PG8_SB(1, 1), b3 + hstep, voffB); PG8_STAGE(PG8_SA(1, 0), a3, voffA);
            PG8_WAIT_V(8); PG8_WAIT_L(0); PG8_BAR; PG8_MMA(1, 0, At, B0); PG8_MMA(1, 1, At, B1); PG8_BAR; PG8_SCHED;
            } else {
            PG8_LDB(B0, 0, 0); PG8_SCHED; PG8_LDA(At, 0, 0); PG8_STAGE(PG8_SA(1, 1), a1 + hstep, voffA);
            PG8_WAIT_L(8); PG8_BAR; PG8_WAIT_L(0); PG8_MMA(0, 0, At, B0); PG8_BAR; PG8_SCHED;
            PG8_LDB(B1, 0, 1); PG8_STAGE(PG8_SB(0, 0), b2, voffB);
            PG8_BAR; PG8_WAIT_L(0); PG8_MMA(0, 1, At, B1); PG8_BAR;
            PG8_LDA(At, 0, 1); PG8_STAGE(PG8_SA(0, 0), a2, voffA);
            PG8_BAR; PG8_WAIT_L(0); PG8_MMA(1, 0, At, B0); PG8_BAR; PG8_SCHED;
            PG8_STAGE(PG8_SB(0, 1), b2 + hstep, voffB);
            PG8_WAIT_V(6); PG8_BAR; PG8_MMA(1, 1, At, B1); PG8_BAR;
            PG8_LDB(B0, 1, 0); PG8_SCHED; PG8_LDA(At, 1, 0); PG8_STAGE(PG8_SA(0, 1), a2 + hstep, voffA);
            PG8_WAIT_L(8); PG8_BAR; PG8_WAIT_L(0); PG8_MMA(0, 0, At, B0); PG8_BAR; PG8_SCHED;
            PG8_LDB(B1, 1, 1); PG8_STAGE(PG8_SB(1, 0), b3, voffB);
            PG8_BAR; PG8_WAIT_L(0); PG8_MMA(0, 1, At, B1); PG8_BAR;
            PG8_LDA(At, 1, 1); PG8_STAGE(PG8_SA(1, 0), a3, voffA);
            PG8_BAR; PG8_WAIT_L(0); PG8_MMA(1, 0, At, B0); PG8_BAR; PG8_SCHED;
            PG8_STAGE(PG8_SB(1, 1), b3 + hstep, voffB);
            PG8_WAIT_V(6); PG8_BAR; PG8_MMA(1, 1, At, B1); PG8_BAR;
            }
        }
        if constexpr (ALIGN_EPI) { if (wr == 0) PG8_BAR; }
        if constexpr (!Epi::AFTER_DRAIN) { E(acc, cur, wr, wc, fr, fq); S.done(cur); }
        if (!has_next) break;
#pragma unroll
        for (int a = 0; a < 2; ++a)
#pragma unroll
            for (int b = 0; b < 2; ++b)
#pragma unroll
                for (int m = 0; m < 4; ++m)
#pragma unroll
                    for (int n = 0; n < 2; ++n) acc[a][b][m][n] = (f32x4){0.f, 0.f, 0.f, 0.f};
        cur = nxt; cA = nA; cB = nB; ++ui;
        if constexpr (ALIGN_EPI) { if (wr == 1) PG8_BAR; }
    }
    PG8_WAIT_V(0);
    if constexpr (!ALIGN_EPI) { if (wr == 0) PG8_BAR; }
    PG8_BAR;
    if constexpr (Epi::AFTER_DRAIN) { E.fused(acc, cur, wr, wc, fr, fq, lds, wid, lane); S.done(cur); }
#undef PG8_SA
#undef PG8_SB
#undef PG8_STAGE
#undef PG8_LDA
#undef PG8_LDB
#undef PG8_MMA
#undef PG8_WAIT_V
#undef PG8_WAIT_L
#undef PG8_BAR
#undef PG8_SCHED
}
}
#define GAS __attribute__((address_space(1)))
#define LAS __attribute__((address_space(3)))
typedef unsigned short bf16;
typedef unsigned v4u __attribute__((ext_vector_type(4)));
typedef float f32x4 __attribute__((ext_vector_type(4)));
typedef short bf16x8 __attribute__((ext_vector_type(8)));
typedef GAS unsigned gu32;
typedef GAS unsigned long long gu64;
#define RLX_AGENT __ATOMIC_RELAXED, __HIP_MEMORY_SCOPE_AGENT
#define LDS_WAIT() asm volatile("s_waitcnt lgkmcnt(0)" ::: "memory")
#define VM_WAIT() asm volatile("s_waitcnt vmcnt(0)" ::: "memory")
__device__ __forceinline__ unsigned long long rt() { return __builtin_amdgcn_s_memrealtime(); }
__device__ __forceinline__ unsigned f2bf(float f) { unsigned u = __builtin_bit_cast(unsigned, f); return (u + 0x7fffu + ((u >> 16) & 1u)) >> 16; }
__device__ __forceinline__ unsigned pk2(float lo, float hi) { return f2bf(lo) | (f2bf(hi) << 16); }

#define XB_TMO      128
#define XB_XCNT(j)  (256  + 64 * (j))
#define XB_XSUB(j)  (1280 + 64 * (j))
#define XB_XGEN(j)  (2304 + 64 * (j))
#define XB_TOP      3328
#define XB_TOPGEN   3392
#define XCD_BAR_WORDS 3456
#define XB_SPIN_CAP (1u << 18)

__device__ __forceinline__ unsigned xb_ld(unsigned* p)              { return __hip_atomic_load(p, __ATOMIC_RELAXED, __HIP_MEMORY_SCOPE_AGENT); }
__device__ __forceinline__ unsigned xb_add(unsigned* p, unsigned v) { return __hip_atomic_fetch_add(p, v, __ATOMIC_RELAXED, __HIP_MEMORY_SCOPE_AGENT); }
__device__ __forceinline__ unsigned xb_xcc_id() { return (unsigned)__builtin_amdgcn_s_getreg((3 << 11) | 20) & 0xFu; }
#define XB_SPIN(cond, bar) do { unsigned _sp = 0; while (cond) { __builtin_amdgcn_s_sleep(1); \
    if ((++_sp & 255u) == 0u) { if (xb_ld(&(bar)[XB_TMO])) break; if (_sp > XB_SPIN_CAP) { atomicAdd(&(bar)[XB_TMO], 1u); break; } } } } while (0)

struct XcdBarrier {
    unsigned* bar; unsigned x;
    volatile LAS unsigned* st;
};

__device__ __forceinline__ XcdBarrier xcd_barrier_post(unsigned* bar, volatile LAS unsigned* st) {
    XcdBarrier b; b.bar = bar; b.x = xb_xcc_id(); b.st = st;
    if (threadIdx.x == 0) (void)xb_add(&bar[XB_XCNT(b.x)], 1u);
    return b;
}
__device__ __forceinline__ void xcd_barrier_complete(unsigned* bar, unsigned x, unsigned& nloc, unsigned& nx) {
    const unsigned G = gridDim.x * gridDim.y * gridDim.z;
    unsigned sum, cnt, mine, sp = 0u;
    for (;;) {
        sum = 0u; cnt = 0u; mine = 0u;
#pragma unroll
        for (unsigned j = 0; j < 16; ++j) { const unsigned c = xb_ld(&bar[XB_XCNT(j)]); sum += c; cnt += (c > 0u) ? 1u : 0u; mine = (j == x) ? c : mine; }
        if (sum == G) break;
        __builtin_amdgcn_s_sleep(1);
        if ((++sp & 255u) == 0u) { if (xb_ld(&bar[XB_TMO])) break; if (sp > XB_SPIN_CAP) { atomicAdd(&bar[XB_TMO], 1u); break; } }
    }
    nloc = mine > 0u ? mine : 1u; nx = cnt > 0u ? cnt : 1u;
}

__device__ __forceinline__ void xcd_barrier(const XcdBarrier& b) {
    asm volatile("s_waitcnt vmcnt(0)" ::: "memory");
    __syncthreads();
    if (threadIdx.x == 0) {
        unsigned* bar = b.bar;
        __builtin_amdgcn_s_waitcnt(0);
        unsigned nloc = b.st[0], nx = b.st[1];
        if (nloc == 0u) { xcd_barrier_complete(bar, b.x, nloc, nx); b.st[0] = nloc; b.st[1] = nx; }
        const unsigned old = xb_add(&bar[XB_XSUB(b.x)], 1u);
        const unsigned gen = old / nloc;
        if (old + 1u == (gen + 1u) * nloc) {
            __builtin_amdgcn_fence(__ATOMIC_RELEASE, "agent");
            asm volatile("s_waitcnt vmcnt(0)" ::: "memory");
            const unsigned og = xb_add(&bar[XB_TOP], 1u);
            const unsigned tg = og / nx;
            if (og + 1u == (tg + 1u) * nx) xb_add(&bar[XB_TOPGEN], 1u);
            else XB_SPIN(xb_ld(&bar[XB_TOPGEN]) == tg, bar);
            __builtin_amdgcn_fence(__ATOMIC_ACQUIRE, "agent");
            xb_add(&bar[XB_XGEN(b.x)], 1u);
            asm volatile("s_waitcnt vmcnt(0)" ::: "memory");
        } else {
            XB_SPIN(xb_ld(&bar[XB_XGEN(b.x)]) == gen, bar);
            __builtin_amdgcn_fence(__ATOMIC_ACQUIRE, "agent");
            asm volatile("s_waitcnt vmcnt(0)" ::: "memory");
        }
    }
    __syncthreads();
}

constexpr int BATCH = 2, SEQ = 4096, DM = 2048, MTOK = BATCH * SEQ, DEPTH = 4;
constexpr int NH = 32, NKV = 4, HD = 64, QD = 2048, KVD = 256;
constexpr int A_IN = 2560, B_IN = 7680, C_IN = 3664, C_INP = 3840;
constexpr int DFF = 5632, NGU = 2 * DFF;
constexpr int IDXH = 16, IDXD = 64, TOPK = 256;
constexpr int C_QI = 2560, C_KI = 3584, C_WI = 3648;
constexpr float ALPHA = 1.6817928305074290f;
constexpr float LN_EPS = 1e-5f;
constexpr float LOG2E = 1.4426950408889634f;
constexpr float C2 = 0.125f * LOG2E;

constexpr size_t MiB = 1u << 20;
constexpr size_t WS_CTL = 0, CTL_ZERO_BYTES = 1 * MiB;
constexpr size_t WS_W_AIN = 2 * MiB;
constexpr size_t WS_W_AOUT = WS_W_AIN + 20 * MiB;
constexpr size_t WS_W_BIN = WS_W_AOUT + 16 * MiB;
constexpr size_t WS_W_BOUT = WS_W_BIN + 30 * MiB;
constexpr size_t WS_W_CIN = WS_W_BOUT + 8 * MiB;
constexpr size_t WS_W_COUT = WS_W_CIN + 15 * MiB;
constexpr size_t WS_W_GU = WS_W_COUT + 8 * MiB;
constexpr size_t WS_W_DN = WS_W_GU + 176 * MiB;
constexpr size_t WS_X = WS_W_DN + 88 * MiB;
constexpr size_t WS_XB = WS_X + 64 * MiB;
constexpr size_t WS_Z = WS_XB + 32 * MiB;
constexpr size_t WS_O = WS_Z + 64 * MiB;
constexpr size_t WS_MASK = WS_O + 32 * MiB;
constexpr size_t WS_QKV = WS_MASK + 4 * MiB;
constexpr size_t WS_H = WS_QKV + 120 * MiB;
constexpr size_t WS_SC = WS_H;
constexpr size_t WS_END = WS_H + 128 * MiB;
constexpr int CW_BAR = 4096;

constexpr int RING_BYTES = 131072;
constexpr int LDSCTL_OFF = RING_BYTES, MISC_OFF = LDSCTL_OFF + 320;
constexpr int LDS_BYTES = 147456;
constexpr int NWAVES = 8;

typedef unsigned long long u64;
#define OPAQUE_V(x) asm volatile("" : "+v"(x))
#define OPAQUE_S(x) asm volatile("" : "+s"(x))

__device__ __forceinline__ float bf_lo(unsigned u) { return __uint_as_float(u << 16); }
__device__ __forceinline__ float bf_hi(unsigned u) { return __uint_as_float(u & 0xffff0000u); }
__device__ __forceinline__ float wave_sum(float v) {
#pragma unroll
    for (int o = 1; o < 64; o <<= 1) v += __shfl_xor(v, o);
    return v;
}
__device__ __forceinline__ unsigned wave_sum_u(unsigned v) {
#pragma unroll
    for (int o = 1; o < 64; o <<= 1) v += (unsigned)__shfl_xor((int)v, o);
    return v;
}

__device__ __forceinline__ void conv_item(const float* W, int K, int N, int Npad, bf16* WT, int mode, LAS float* scr, int item, int lane) {
    const int nblk = Npad / 64, kb = item / nblk, nb = item % nblk, k0 = 64 * kb, n0 = 64 * nb;
    const int ncol = n0 + lane; const bool nok = ncol < N;
    const float* wp = W + (size_t)k0 * N + ncol;
    float wreg[64];
#pragma unroll
    for (int i = 0; i < 64; ++i) wreg[i] = nok ? wp[(size_t)i * N] : 0.f;
#pragma unroll
    for (int i = 0; i < 64; ++i) scr[i * 64 + (lane ^ (i & 31))] = wreg[i];
    LDS_WAIT(); asm volatile("" ::: "memory");
    int row0 = n0;
    if (mode == 1) { if (n0 < DFF) row0 = 256 * (n0 / 128) + (n0 % 128); else { const int c = n0 - DFF; row0 = 256 * (c / 128) + 128 + (c % 128); } }
    const int c = lane & 7, nl = lane >> 3;
#pragma unroll
    for (int j = 0; j < 8; ++j) { const int n = nl + 8 * j; float e[8];
#pragma unroll
        for (int q = 0; q < 8; ++q) e[q] = scr[(8 * c + q) * 64 + (n ^ ((8 * c + q) & 31))];
        v4u o; o.x = pk2(e[0], e[1]); o.y = pk2(e[2], e[3]); o.z = pk2(e[4], e[5]); o.w = pk2(e[6], e[7]);
        *(GAS v4u*)(WT + (size_t)(row0 + n) * K + k0 + 8 * c) = o; }
    LDS_WAIT(); asm volatile("" ::: "memory");
}

struct Params {
    const float* x; const float* a_w_in; const float* a_sinks; const float* a_w_out; const float* b_w_in; const float* b_w_out;
    const float* c_w_in; const float* c_w_out; const float* ln_g; const float* ln_b; const float* w_gu; const float* w_dn;
    float* out; unsigned char* ws;
    int ph_lo, ph_hi, li, pad;
};

__device__ __forceinline__ void prologue_phase(const Params& p, LAS unsigned char* lds, int gw, int NGW, int wave, int lane) {
    OPAQUE_V(lane); OPAQUE_S(gw); OPAQUE_S(wave);
    LAS float* scr = (LAS float*)(lds + wave * 16384);
    unsigned char* ws = p.ws;
    for (int mi = 0; mi < 16; ++mi) {
        const float* W; bf16* WT; int K, N, Npad, mode = 0;
        if (mi < 2)       { W = p.a_w_in + (size_t)mi * DM * A_IN;  WT = (bf16*)(ws + WS_W_AIN) + (size_t)mi * A_IN * DM;  K = DM; N = A_IN; Npad = A_IN; }
        else if (mi < 4)  { W = p.a_w_out + (size_t)(mi - 2) * QD * DM; WT = (bf16*)(ws + WS_W_AOUT) + (size_t)(mi - 2) * DM * QD; K = QD; N = DM; Npad = DM; }
        else if (mi == 4) { W = p.b_w_in;  WT = (bf16*)(ws + WS_W_BIN);  K = DM; N = B_IN; Npad = B_IN; }
        else if (mi == 5) { W = p.b_w_out; WT = (bf16*)(ws + WS_W_BOUT); K = QD; N = DM; Npad = DM; }
        else if (mi == 6) { W = p.c_w_in;  WT = (bf16*)(ws + WS_W_CIN);  K = DM; N = C_IN; Npad = C_INP; }
        else if (mi == 7) { W = p.c_w_out; WT = (bf16*)(ws + WS_W_COUT); K = QD; N = DM; Npad = DM; }
        else if (mi < 12) { W = p.w_gu + (size_t)(mi - 8) * DM * NGU; WT = (bf16*)(ws + WS_W_GU) + (size_t)(mi - 8) * NGU * DM; K = DM; N = NGU; Npad = NGU; mode = 1; }
        else              { W = p.w_dn + (size_t)(mi - 12) * DFF * DM; WT = (bf16*)(ws + WS_W_DN) + (size_t)(mi - 12) * DM * DFF; K = DFF; N = DM; Npad = DM; }
        const int items = (K / 64) * (Npad / 64);
        for (int it = gw; it < items; it += NGW) conv_item(W, K, N, Npad, WT, mode, scr, it, lane);
    }
    bf16* XB = (bf16*)(ws + WS_XB);
    for (int m = gw; m < MTOK; m += NGW) {
        const GAS f32x4* xr = (const GAS f32x4*)(p.x + (size_t)m * DM) + lane; GAS u64* o8 = (GAS u64*)(XB + (size_t)m * DM) + lane;
#pragma unroll
        for (int j = 0; j < 8; ++j) { const f32x4 v = xr[64 * j]; o8[64 * j] = (u64)pk2(v.x, v.y) | ((u64)pk2(v.z, v.w) << 32); }
    }
}

__device__ __forceinline__ void ln_phase(const float* Z, const float* g, const float* b, float* Xo, bf16* XBo, int gw, int NGW, int lane) {
    OPAQUE_V(lane); OPAQUE_S(gw);
    for (int m = gw; m < MTOK; m += NGW) {
        const GAS f32x4* zr = (const GAS f32x4*)(Z + (size_t)m * DM) + lane;
        f32x4 v[8]; float s = 0.f;
#pragma unroll
        for (int j = 0; j < 8; ++j) { v[j] = zr[64 * j]; s += (v[j].x + v[j].y) + (v[j].z + v[j].w); }
        const float mean = wave_sum(s) * (1.f / DM); float s2 = 0.f;
#pragma unroll
        for (int j = 0; j < 8; ++j) { v[j] = v[j] - mean; s2 += (v[j].x * v[j].x + v[j].y * v[j].y) + (v[j].z * v[j].z + v[j].w * v[j].w); }
        const float rstd = 1.f / sqrtf(wave_sum(s2) * (1.f / DM) + LN_EPS);
        GAS f32x4* xo = (GAS f32x4*)(Xo + (size_t)m * DM) + lane; GAS u64* o8 = (GAS u64*)(XBo + (size_t)m * DM) + lane;
#pragma unroll
        for (int j = 0; j < 8; ++j) { const f32x4 gg = ((const f32x4*)g)[lane + 64 * j], bb = ((const f32x4*)b)[lane + 64 * j];
            const f32x4 y = v[j] * rstd * gg + bb; xo[64 * j] = y; o8[64 * j] = (u64)pk2(y.x, y.y) | ((u64)pk2(y.z, y.w) << 32); }
    }
}

__device__ __forceinline__ void load_row64(const bf16* p, float (&f)[64]) {
    const GAS v4u* q = (const GAS v4u*)p;
#pragma unroll
    for (int i = 0; i < 8; ++i) { const v4u w = q[i];
        f[8 * i + 0] = bf_lo(w.x); f[8 * i + 1] = bf_hi(w.x); f[8 * i + 2] = bf_lo(w.y); f[8 * i + 3] = bf_hi(w.y);
        f[8 * i + 4] = bf_lo(w.z); f[8 * i + 5] = bf_hi(w.z); f[8 * i + 6] = bf_lo(w.w); f[8 * i + 7] = bf_hi(w.w); }
}
__device__ __forceinline__ void attn_key(const float (&q)[64], const bf16* kp, const bf16* vp, float bias, float (&o)[64], float& m, float& l) {
    float s0 = 0.f, s1 = 0.f;
    { const GAS v4u* kq = (const GAS v4u*)kp;
#pragma unroll
      for (int i = 0; i < 8; ++i) { const v4u w = kq[i];
        s0 += q[8 * i + 0] * bf_lo(w.x); s1 += q[8 * i + 1] * bf_hi(w.x); s0 += q[8 * i + 2] * bf_lo(w.y); s1 += q[8 * i + 3] * bf_hi(w.y);
        s0 += q[8 * i + 4] * bf_lo(w.z); s1 += q[8 * i + 5] * bf_hi(w.z); s0 += q[8 * i + 6] * bf_lo(w.w); s1 += q[8 * i + 7] * bf_hi(w.w); } }
    const float s = (s0 + s1) + bias;
    if (s > m) { const float f = __builtin_amdgcn_exp2f(m - s); l *= f;
#pragma unroll
        for (int i = 0; i < 64; ++i) o[i] *= f;
        m = s; }
    const float pp = __builtin_amdgcn_exp2f(s - m); l += pp;
    { const GAS v4u* vq = (const GAS v4u*)vp;
#pragma unroll
      for (int i = 0; i < 8; ++i) { const v4u w = vq[i];
        o[8 * i + 0] += pp * bf_lo(w.x); o[8 * i + 1] += pp * bf_hi(w.x); o[8 * i + 2] += pp * bf_lo(w.y); o[8 * i + 3] += pp * bf_hi(w.y);
        o[8 * i + 4] += pp * bf_lo(w.z); o[8 * i + 5] += pp * bf_hi(w.z); o[8 * i + 6] += pp * bf_lo(w.w); o[8 * i + 7] += pp * bf_hi(w.w); } }
}
__device__ __forceinline__ void naive_attn_phase(int kind, const bf16* QKV, int pitch, const float* sinks, const unsigned* mask32, bf16* O, int gw, int NGW, int lane) {
    OPAQUE_V(lane); OPAQUE_S(gw);
    for (int task = gw; task < BATCH * 64 * NH; task += NGW) {
        const int h = task & 31, tb = (task >> 5) & 63, b = task >> 11;
        const int t = tb * 64 + lane; const size_t row = (size_t)b * SEQ + t; const int kvh = h >> 3;
        const float slope = exp2f(-0.25f * (float)(h + 1)) * LOG2E;
        float o[64];
#pragma unroll
        for (int i = 0; i < 64; ++i) o[i] = 0.f;
        float m = -INFINITY, l = 0.f;
        if (kind == 0) { m = sinks[h] * LOG2E; l = 1.f; }
        const int ng = (kind == 1) ? 3 : 1;
        for (int g = 0; g < ng; ++g) {
            float q[64]; load_row64(QKV + row * pitch + g * A_IN + h * HD, q);
            const bf16* kbase = QKV + (size_t)b * SEQ * pitch + g * A_IN + QD + kvh * HD;
            if (kind != 2) {
                const int d = (g == 0) ? 1 : (g == 1 ? 4 : 16); const int W = (kind == 0) ? 128 : 129;
                for (int j = 0; j < W; ++j) { const int pos = t - j * d;
                    if (pos >= 0) { const bf16* kp = kbase + (size_t)pos * pitch; attn_key(q, kp, kp + KVD, -slope * (float)(j * d), o, m, l); } }
            } else {
                const unsigned* mr = mask32 + row * 128;
                for (int w = 0; w <= (t >> 5); ++w) { unsigned bits = mr[w];
                    while (bits) { const int i = __builtin_ctz(bits); bits &= bits - 1u; const int pos = 32 * w + i;
                        const bf16* kp = kbase + (size_t)pos * pitch; attn_key(q, kp, kp + KVD, -slope * (float)(t - pos), o, m, l); } }
            }
        }
        const float rl = 1.f / l; GAS v4u* op = (GAS v4u*)(O + row * QD + h * HD);
#pragma unroll
        for (int i = 0; i < 8; ++i) { v4u w; w.x = pk2(o[8 * i] * rl, o[8 * i + 1] * rl); w.y = pk2(o[8 * i + 2] * rl, o[8 * i + 3] * rl);
            w.z = pk2(o[8 * i + 4] * rl, o[8 * i + 5] * rl); w.w = pk2(o[8 * i + 6] * rl, o[8 * i + 7] * rl); op[i] = w; }
    }
}

__device__ __forceinline__ void naive_score_phase(const bf16* P, float* SC, LAS unsigned char* lds, int gw, int NGW, int wave, int lane) {
    OPAQUE_V(lane); OPAQUE_S(gw); OPAQUE_S(wave);
    LAS float* qs = (LAS float*)(lds + wave * 8192);
    LAS float* wsc = qs + IDXH * IDXD;
    for (int it = gw; it < 2 * SEQ; it += NGW) {
        const int i = it / (SEQ / 2), w = it % (SEQ / 2);
        const int base = (i >> 1) * SEQ; const int t = (i & 1) ? (SEQ - 1 - w) : w;
        const size_t row = (size_t)base + t;
        { const GAS v4u* qp = (const GAS v4u*)(P + row * C_INP + C_QI) + 2 * lane;
          const v4u a = qp[0], c = qp[1]; LAS float* d = qs + 16 * lane;
          d[0] = bf_lo(a.x); d[1] = bf_hi(a.x); d[2] = bf_lo(a.y); d[3] = bf_hi(a.y); d[4] = bf_lo(a.z); d[5] = bf_hi(a.z); d[6] = bf_lo(a.w); d[7] = bf_hi(a.w);
          d[8] = bf_lo(c.x); d[9] = bf_hi(c.x); d[10] = bf_lo(c.y); d[11] = bf_hi(c.y); d[12] = bf_lo(c.z); d[13] = bf_hi(c.z); d[14] = bf_lo(c.w); d[15] = bf_hi(c.w);
          if (lane < IDXH) { const unsigned short wv = *(const GAS unsigned short*)(P + row * C_INP + C_WI + lane); wsc[lane] = __uint_as_float((unsigned)wv << 16) * (0.25f * 0.125f); } }
        LDS_WAIT(); asm volatile("" ::: "memory");
        for (int kb = 0; kb <= (t >> 6); ++kb) {
            const int s = kb * 64 + lane; float kf[64]; load_row64(P + ((size_t)base + s) * C_INP + C_KI, kf);
            float sc = 0.f;
            for (int h = 0; h < IDXH; ++h) { float a0 = 0.f, a1 = 0.f;
#pragma unroll
                for (int d = 0; d < 64; d += 2) { a0 += qs[h * 64 + d] * kf[d]; a1 += qs[h * 64 + d + 1] * kf[d + 1]; }
                sc += wsc[h] * fmaxf(a0 + a1, 0.f); }
            SC[row * SEQ + s] = sc;
        }
        LDS_WAIT(); asm volatile("" ::: "memory");
    }
}

__device__ __forceinline__ unsigned fkey(float f) { const unsigned u = __float_as_uint(f); return (u & 0x80000000u) ? ~u : (u | 0x80000000u); }
__device__ __forceinline__ void select_phase(const float* SC, u64* MASK, int gw, int NGW, int lane) {
    OPAQUE_V(lane); OPAQUE_S(gw);
    for (int row = gw; row < MTOK; row += NGW) {
        const int t = row & (SEQ - 1); const int nblk = (t >> 6) + 1;
        const float* sr = SC + (size_t)row * SEQ;
        u64* mrow = MASK + (size_t)row * 64;
        if (t < TOPK) {
            for (int i = 0; i < nblk; ++i) { const u64 bits = __ballot(64 * i + lane <= t); if (lane == 0) mrow[i] = bits; }
            continue;
        }
        unsigned u[64];
#pragma unroll
        for (int i = 0; i < 64; ++i) { const int e = 64 * i + lane; u[i] = 0u; if (i < nblk) { if (e <= t) u[i] = fkey(sr[e]); } }
        unsigned T = 0u;
        for (int bit = 31; bit >= 0; --bit) {
            const unsigned cand = T | (1u << bit); unsigned c = 0u;
#pragma unroll
            for (int i = 0; i < 64; ++i) c += (u[i] >= cand) ? 1u : 0u;
            c = wave_sum_u(c);
            if (c >= (unsigned)TOPK) T = cand;
        }
        unsigned cg = 0u;
#pragma unroll
        for (int i = 0; i < 64; ++i) cg += (u[i] > T) ? 1u : 0u;
        cg = wave_sum_u(cg);
        const unsigned need = (unsigned)TOPK - cg; unsigned run = 0u;
        const u64 ltmask = (lane == 0) ? 0ull : (~0ull >> (64 - lane));
#pragma unroll
        for (int i = 0; i < 64; ++i) {
            if (i < nblk) {
                const bool gt = u[i] > T, eq = u[i] == T; const u64 eqm = __ballot(eq);
                const unsigned rank = run + (unsigned)__popcll(eqm & ltmask);
                const u64 bits = __ballot(gt || (eq && rank < need)); run += (unsigned)__popcll(eqm);
                if (lane == 0) mrow[i] = bits;
            }
        }
    }
}


namespace att {
typedef short bf16x8 __attribute__((ext_vector_type(8)));
typedef float f32x16 __attribute__((ext_vector_type(16)));
typedef short s16x4 __attribute__((ext_vector_type(4)));
typedef short v4i16_t __attribute__((ext_vector_type(4)));
#define ATT_CR(r) (((r) & 3) + 8 * ((r) >> 2))
constexpr float NEG_BIG = -1.0e30f;
constexpr int BUFB = 16384;

__device__ __forceinline__ s16x4 vtr(const LAS unsigned char* p) { return __builtin_bit_cast(s16x4, __builtin_amdgcn_ds_read_tr16_b64_v4i16((LAS v4i16_t*)p)); }
__device__ __forceinline__ float xhalf_max(float v) { auto rr = __builtin_amdgcn_permlane32_swap(__float_as_uint(v), __float_as_uint(v), false, false); return fmaxf(__uint_as_float(rr[0]), __uint_as_float(rr[1])); }
__device__ __forceinline__ float xhalf_sum(float v) { auto rr = __builtin_amdgcn_permlane32_swap(__float_as_uint(v), __float_as_uint(v), false, false); return __uint_as_float(rr[0]) + __uint_as_float(rr[1]); }
__device__ __forceinline__ unsigned cvtpk(float lo, float hi) { typedef float f2 __attribute__((ext_vector_type(2))); typedef __bf16 b2 __attribute__((ext_vector_type(2))); f2 v = {lo, hi}; b2 b = __builtin_convertvector(v, b2); return __builtin_bit_cast(unsigned, b); }

__device__ __forceinline__ void attn_phase(int kind, const bf16* P, int pitch, const float* sinks, const u64* MASK, bf16* Oout, LAS unsigned char* lds, int G) {
    int tid = threadIdx.x; OPAQUE_V(tid);
    const int lane = tid & 63, wave = __builtin_amdgcn_readfirstlane(tid >> 6), l31 = lane & 31, hi = lane >> 5;
    int koff[4];
#pragma unroll
    for (int s = 0; s < 4; ++s) koff[s] = l31 * 128 + (((2 * s + hi) ^ ((l31 >> 1) & 7)) << 4);
    const int q4 = (lane & 15) >> 2, g1 = (lane >> 4) & 1, p4 = lane & 3, fV = (q4 >> 1) & 1;
    int voff[2];
#pragma unroll
    for (int db = 0; db < 2; ++db) voff[db] = 8192 + (4 * hi + q4) * 128 + ((((db ^ fV) << 2) + 2 * g1 + (p4 >> 1)) << 4) + 8 * (p4 & 1);
    const int srow = tid >> 3, spc = tid & 7;
    const int skoff = srow * 128 + ((spc ^ ((srow >> 1) & 7)) << 4);
    const int svoff = 8192 + srow * 128 + ((spc ^ (((srow >> 1) & 1) << 2)) << 4);
    const bool useMask = (kind == 2);
    const int ng = (kind == 1) ? 3 : 1;

    for (int it = 0;; ++it) {
        const int v = it * G + (int)blockIdx.x; if (v >= 1024) break;
        const int combo = v & 7, qq = v >> 3, jq = qq & 31, kq = qq >> 5;
        const int tile = (kq == 0) ? jq : (kq == 1) ? 63 - jq : (kq == 2) ? 64 + jq : 127 - jq;
        const int b = combo >> 2, kvh = combo & 3, h = kvh * 8 + wave;
        const float slope = exp2f(-0.25f * (float)(h + 1)) * LOG2E;
        const int T0 = (kind == 1) ? (512 * (tile >> 4) + (tile & 15)) : 32 * tile;
        const int qstride = (kind == 1) ? 16 : 1;
        const size_t brow = (size_t)b * SEQ;
        const size_t qrow = brow + T0 + l31 * qstride;
        f32x16 O0, O1;
#pragma unroll
        for (int r = 0; r < 16; ++r) { O0[r] = 0.f; O1[r] = 0.f; }
        float m = NEG_BIG, lsum = 0.f;
        if (kind == 0) { m = sinks[h] * LOG2E; lsum = (hi == 0) ? 1.f : 0.f; }

        for (int g = 0; g < ng; ++g) {
            const int dsh = (kind == 1) ? 2 * g : 0, d = 1 << dsh;
            const int W = (kind == 0) ? 128 : (kind == 1) ? 129 : (1 << 20);
            const int qs = qstride >> dsh;
            const int cbase = g * A_IN;
            const int res = T0 & (d - 1), u0 = T0 >> dsh;
            const int uq = u0 + l31 * qs, khi = u0 + 31 * qs;
            int klo = u0 - (W - 1); klo = (klo < 0 ? 0 : klo) & ~31;
            const int nsub = ((khi - klo) >> 5) + 1, nch = (nsub + 1) >> 1;
            const float c1 = slope * (float)d;
            bf16x8 qf[4];
#pragma unroll
            for (int s = 0; s < 4; ++s) qf[s] = *(const GAS bf16x8*)(P + qrow * pitch + cbase + h * HD + 16 * s + 8 * hi);
            const bf16* kcol = P + cbase + QD + kvh * HD + spc * 8;
            v4u kreg, vreg; u64 mw = 0ull, mwn = 0ull;
            { int tok = (klo + srow) * d + res; tok = tok > SEQ - 1 ? SEQ - 1 : tok; const bf16* kp = kcol + (brow + tok) * pitch;
              kreg = *(const GAS v4u*)kp; vreg = *(const GAS v4u*)(kp + KVD);
              if (useMask) mw = MASK[qrow * 64 + (klo >> 6)]; }
            *(LAS v4u*)(lds + skoff) = kreg; *(LAS v4u*)(lds + svoff) = vreg;
            __syncthreads();
            for (int c = 0; c < nch; ++c) {
                const int kidxc = klo + 64 * c; const int bufo = (c & 1) * BUFB;
                if (c + 1 < nch) { int tok = (kidxc + 64 + srow) * d + res; tok = tok > SEQ - 1 ? SEQ - 1 : tok; const bf16* kp = kcol + (brow + tok) * pitch;
                    kreg = *(const GAS v4u*)kp; vreg = *(const GAS v4u*)(kp + KVD);
                    if (useMask) mwn = MASK[qrow * 64 + ((kidxc + 64) >> 6)]; }
#pragma unroll
                for (int sub = 0; sub < 2; ++sub) {
                    if (2 * c + sub < nsub) {
                        const int kidx0 = kidxc + 32 * sub;
                        const int dq = uq - kidx0 - 4 * hi;
                        const float base = c1 * (float)(-dq);
                        f32x16 S;
#pragma unroll
                        for (int r = 0; r < 16; ++r) S[r] = fmaf((float)ATT_CR(r), c1, base);
                        const LAS unsigned char* kb = lds + bufo + sub * 4096;
#pragma unroll
                        for (int s = 0; s < 4; ++s) { const bf16x8 kf = *(const LAS bf16x8*)(kb + koff[s]); S = __builtin_amdgcn_mfma_f32_32x32x16_bf16(kf, qf[s], S, 0, 0, 0); }
                        const bool full = (u0 - (kidx0 + 31) >= 0) && (khi - kidx0 <= W - 1);
                        if (!full) {
#pragma unroll
                            for (int r = 0; r < 16; ++r) { const int dist = dq - ATT_CR(r); if ((unsigned)dist >= (unsigned)W) S[r] = NEG_BIG; }
                        }
                        if (useMask) { const unsigned mws = (unsigned)(mw >> (32 * sub)) >> (4 * hi);
#pragma unroll
                            for (int r = 0; r < 16; ++r) { if (((mws >> ATT_CR(r)) & 1u) == 0u) S[r] = NEG_BIG; }
                        }
                        float mloc = fmaxf(fmaxf(S[0], S[1]), fmaxf(S[2], S[3]));
#pragma unroll
                        for (int r = 4; r < 16; r += 4) mloc = fmaxf(mloc, fmaxf(fmaxf(S[r], S[r + 1]), fmaxf(S[r + 2], S[r + 3])));
                        const float mnew = fmaxf(m, xhalf_max(mloc));
                        if (__any(mnew > m)) { const float al = __builtin_amdgcn_exp2f(m - mnew); lsum *= al;
#pragma unroll
                            for (int r = 0; r < 16; ++r) { O0[r] *= al; O1[r] *= al; }
                            m = mnew; }
                        float ps = 0.f;
#pragma unroll
                        for (int r = 0; r < 16; ++r) { S[r] = __builtin_amdgcn_exp2f(S[r] - m); ps += S[r]; }
                        lsum += ps;
                        v4u pa, pb;
                        pa.x = cvtpk(S[0], S[1]); pa.y = cvtpk(S[2], S[3]); pa.z = cvtpk(S[4], S[5]); pa.w = cvtpk(S[6], S[7]);
                        pb.x = cvtpk(S[8], S[9]); pb.y = cvtpk(S[10], S[11]); pb.z = cvtpk(S[12], S[13]); pb.w = cvtpk(S[14], S[15]);
                        const bf16x8 P0 = __builtin_bit_cast(bf16x8, pa), P1 = __builtin_bit_cast(bf16x8, pb);
                        const LAS unsigned char* vb = lds + bufo + sub * 4096;
#pragma unroll
                        for (int s = 0; s < 2; ++s) {
                            const s16x4 a0l = vtr(vb + voff[0] + s * 2048), a0h = vtr(vb + voff[0] + s * 2048 + 1024);
                            const s16x4 a1l = vtr(vb + voff[1] + s * 2048), a1h = vtr(vb + voff[1] + s * 2048 + 1024);
                            const bf16x8 A0 = (bf16x8){a0l[0], a0l[1], a0l[2], a0l[3], a0h[0], a0h[1], a0h[2], a0h[3]};
                            const bf16x8 A1 = (bf16x8){a1l[0], a1l[1], a1l[2], a1l[3], a1h[0], a1h[1], a1h[2], a1h[3]};
                            O0 = __builtin_amdgcn_mfma_f32_32x32x16_bf16(A0, s == 0 ? P0 : P1, O0, 0, 0, 0);
                            O1 = __builtin_amdgcn_mfma_f32_32x32x16_bf16(A1, s == 0 ? P0 : P1, O1, 0, 0, 0);
                        }
                    }
                }
                if (c + 1 < nch) { const int bo = ((c + 1) & 1) * BUFB; *(LAS v4u*)(lds + bo + skoff) = kreg; *(LAS v4u*)(lds + bo + svoff) = vreg; mw = mwn; }
                __syncthreads();
            }
        }
        const float rl = 1.0f / xhalf_sum(lsum);
        bf16* op = Oout + qrow * QD + h * HD + 4 * hi;
#pragma unroll
        for (int rq = 0; rq < 4; ++rq) {
            const u64 w0 = (u64)cvtpk(O0[4 * rq] * rl, O0[4 * rq + 1] * rl) | ((u64)cvtpk(O0[4 * rq + 2] * rl, O0[4 * rq + 3] * rl) << 32);
            const u64 w1 = (u64)cvtpk(O1[4 * rq] * rl, O1[4 * rq + 1] * rl) | ((u64)cvtpk(O1[4 * rq + 2] * rl, O1[4 * rq + 3] * rl) << 32);
            *(GAS u64*)(op + 8 * rq) = w0; *(GAS u64*)(op + 32 + 8 * rq) = w1;
        }
    }
}
}

namespace att {
__device__ __forceinline__ void score_phase(const bf16* P, float* SC, LAS unsigned char* lds, int G) {
    int tid = threadIdx.x; OPAQUE_V(tid);
    const int lane = tid & 63, wave = __builtin_amdgcn_readfirstlane(tid >> 6), l31 = lane & 31, hi = lane >> 5;
    int koff[4];
#pragma unroll
    for (int s = 0; s < 4; ++s) koff[s] = l31 * 128 + (((2 * s + hi) ^ ((l31 >> 1) & 7)) << 4);
    const int srow = tid >> 3, spc = tid & 7;
    const int skoff = srow * 128 + ((spc ^ ((srow >> 1) & 7)) << 4);
    for (int it = 0;; ++it) {
        const int v = it * G + (int)blockIdx.x; if (v >= 512) break;
        const int b = v & 1, q = v >> 1, tile = (q < 128) ? q : 383 - q;
        const int t0 = 16 * tile; const size_t brow = (size_t)b * SEQ;
        const int tl = l31 >> 4, hh = l31 & 15;
        const size_t arow = brow + t0 + 2 * wave + tl;
        bf16x8 qa[4];
#pragma unroll
        for (int s = 0; s < 4; ++s) qa[s] = *(const GAS bf16x8*)(P + arow * C_INP + C_QI + hh * IDXD + 16 * s + 8 * hi);
        float wv[2][8];
#pragma unroll
        for (int t2 = 0; t2 < 2; ++t2)
#pragma unroll
            for (int part = 0; part < 2; ++part) { const u64 w4 = *(const GAS u64*)(P + (brow + t0 + 2 * wave + t2) * C_INP + C_WI + 8 * part + 4 * hi);
                wv[t2][4 * part + 0] = bf_lo((unsigned)w4) * 0.03125f; wv[t2][4 * part + 1] = bf_hi((unsigned)w4) * 0.03125f;
                wv[t2][4 * part + 2] = bf_lo((unsigned)(w4 >> 32)) * 0.03125f; wv[t2][4 * part + 3] = bf_hi((unsigned)(w4 >> 32)) * 0.03125f; }
        const int nsub = ((t0 + 15) >> 5) + 1, nch = (nsub + 1) >> 1;
        const bf16* kcol = P + C_KI + spc * 8;
        v4u kreg;
        { int tok = srow; kreg = *(const GAS v4u*)(kcol + (brow + tok) * C_INP); }
        *(LAS v4u*)(lds + skoff) = kreg;
        __syncthreads();
        float* orow = SC + (brow + t0 + 2 * wave + hi) * SEQ + l31;
        for (int c = 0; c < nch; ++c) {
            const int bufo = (c & 1) * BUFB;
            if (c + 1 < nch) { int tok = 64 * (c + 1) + srow; tok = tok > SEQ - 1 ? SEQ - 1 : tok; kreg = *(const GAS v4u*)(kcol + (brow + tok) * C_INP); }
#pragma unroll
            for (int sub = 0; sub < 2; ++sub) {
                if (2 * c + sub < nsub) {
                    f32x16 S;
#pragma unroll
                    for (int r = 0; r < 16; ++r) S[r] = 0.f;
                    const LAS unsigned char* kb = lds + bufo + sub * 4096;
#pragma unroll
                    for (int s = 0; s < 4; ++s) { const bf16x8 kf = *(const LAS bf16x8*)(kb + koff[s]); S = __builtin_amdgcn_mfma_f32_32x32x16_bf16(qa[s], kf, S, 0, 0, 0); }
                    float p0 = 0.f, p1 = 0.f;
#pragma unroll
                    for (int r = 0; r < 8; ++r) { p0 = fmaf(wv[0][r], fmaxf(S[r], 0.f), p0); p1 = fmaf(wv[1][r], fmaxf(S[r + 8], 0.f), p1); }
                    const float x0 = xhalf_sum(p0), x1 = xhalf_sum(p1);
                    orow[64 * c + 32 * sub] = hi ? x1 : x0;
                }
            }
            if (c + 1 < nch) { *(LAS v4u*)(lds + ((c + 1) & 1) * BUFB + skoff) = kreg; }
            __syncthreads();
        }
    }
}
}

#ifndef NEW_ATTN_KINDS
#define NEW_ATTN_KINDS 7
#endif
#ifndef REP_PRO
#define REP_PRO 1
#endif
#ifndef REP_GIN
#define REP_GIN 1
#endif
#ifndef REP_GOUT
#define REP_GOUT 1
#endif
#ifndef REP_GGU
#define REP_GGU 1
#endif
#ifndef REP_GDN
#define REP_GDN 1
#endif
#ifndef REP_LN
#define REP_LN 1
#endif
#ifndef REP_SC
#define REP_SC 1
#endif
#ifndef REP_SEL
#define REP_SEL 1
#endif
#ifndef REP_ATT0
#define REP_ATT0 1
#endif
#ifndef REP_ATT1
#define REP_ATT1 1
#endif
#ifndef REP_ATT2
#define REP_ATT2 1
#endif
#define REPEAT(n) for (int rep_ = 0; rep_ < (n); ++rep_)
constexpr int NPH = 1 + 9 * DEPTH;
__host__ __device__ inline bool phase_exists(int k) { if (k == 0) return true; const int l = (k - 1) / 9, j = (k - 1) % 9; return (j == 1 || j == 2) ? (l % 3 == 2) : true; }

__global__ void __launch_bounds__(NWAVES * 64, 2) fwd_kernel(Params p) {
    extern __shared__ __attribute__((aligned(16))) unsigned char lds_raw[];
    LAS unsigned char* lds = (LAS unsigned char*)lds_raw;
    volatile LAS unsigned* MISC = (volatile LAS unsigned*)(lds + MISC_OFF);
    const int tid = threadIdx.x, lane = tid & 63, wave = __builtin_amdgcn_readfirstlane(tid >> 6);
    const int G = gridDim.x; const int gw = blockIdx.x * NWAVES + wave, NGW = G * NWAVES;
    unsigned char* ws = p.ws;
    gu32* ctl = (gu32*)(ws + WS_CTL);
    for (int u = tid; u < (LDS_BYTES - LDSCTL_OFF) / 4; u += NWAVES * 64) ((LAS unsigned*)(lds + LDSCTL_OFF))[u] = 0u;
    __syncthreads();
    const int lo = p.ph_lo, hi = p.ph_hi;
    XcdBarrier bar; bar.bar = (unsigned*)(ctl + CW_BAR) + p.li * XCD_BAR_WORDS; bar.x = 0; bar.st = nullptr;
    if (hi - lo > 1) bar = xcd_barrier_post((unsigned*)(ctl + CW_BAR) + p.li * XCD_BAR_WORDS, MISC + 8);
#define IN(k) (lo <= (k) && (k) < hi)
#define SEAM(k) do { if ((k) + 1 < hi) xcd_barrier(bar); } while (0)

    bf16* XB = (bf16*)(ws + WS_XB); float* X = (float*)(ws + WS_X); float* Z = (float*)(ws + WS_Z); bf16* O = (bf16*)(ws + WS_O);
    bf16* QKV = (bf16*)(ws + WS_QKV); bf16* H = (bf16*)(ws + WS_H); float* SC = (float*)(ws + WS_SC); u64* MASK = (u64*)(ws + WS_MASK);

    if (IN(0)) REPEAT(REP_PRO) { prologue_phase(p, lds, gw, NGW, wave, lane); SEAM(0); }

    for (int l = 0; l < DEPTH; ++l) {
        const int kind = l % 3, jj = l / 3, pb = 1 + 9 * l;
        const bf16* Win; const bf16* Wout; int Nin;
        if (kind == 0)      { Win = (const bf16*)(ws + WS_W_AIN) + (size_t)jj * A_IN * DM; Wout = (const bf16*)(ws + WS_W_AOUT) + (size_t)jj * DM * QD; Nin = A_IN; }
        else if (kind == 1) { Win = (const bf16*)(ws + WS_W_BIN); Wout = (const bf16*)(ws + WS_W_BOUT); Nin = B_IN; }
        else                { Win = (const bf16*)(ws + WS_W_CIN); Wout = (const bf16*)(ws + WS_W_COUT); Nin = C_INP; }
        const float* xbase = (l == 0) ? p.x : X;

        if (IN(pb + 0)) REPEAT(REP_GIN) {
            pg8::Gemm g{XB, Win, MTOK, Nin, DM}; pg8::StaticOrder S; S.init(MTOK, Nin, G, (int)blockIdx.x);
            pg8::EpiQKV E{QKV, Nin, (kind == 2) ? C_INP : A_IN, QD, C2};
            pg8::gemm_phase<pg8::EpiQKV, pg8::StaticOrder, true, true>(lds, g, S, E);
            SEAM(pb + 0);
        }
        if (kind == 2 && IN(pb + 1)) REPEAT(REP_SC) { att::score_phase(QKV, SC, lds, G); SEAM(pb + 1); }
        if (kind == 2 && IN(pb + 2)) REPEAT(REP_SEL) { select_phase(SC, MASK, gw, NGW, lane); SEAM(pb + 2); }
        if (IN(pb + 3)) REPEAT(kind == 0 ? REP_ATT0 : kind == 1 ? REP_ATT1 : REP_ATT2) {
            if ((NEW_ATTN_KINDS >> kind) & 1) att::attn_phase(kind, QKV, Nin, p.a_sinks + jj * NH, MASK, O, lds, G);
            else naive_attn_phase(kind, QKV, Nin, p.a_sinks + jj * NH, (const unsigned*)MASK, O, gw, NGW, lane);
            SEAM(pb + 3);
        }
        if (IN(pb + 4)) REPEAT(REP_GOUT) {
            pg8::Gemm g{O, Wout, MTOK, DM, QD}; pg8::StaticOrder S; S.init(MTOK, DM, G, (int)blockIdx.x);
            pg8::EpiResid E{xbase, Z, DM, ALPHA};
            pg8::gemm_phase<pg8::EpiResid, pg8::StaticOrder, true, true>(lds, g, S, E);
            SEAM(pb + 4);
        }
        if (IN(pb + 5)) REPEAT(REP_LN) { ln_phase(Z, p.ln_g + (size_t)(2 * l) * DM, p.ln_b + (size_t)(2 * l) * DM, X, XB, gw, NGW, lane); SEAM(pb + 5); }
        if (IN(pb + 6)) REPEAT(REP_GGU) {
            pg8::Gemm g{XB, (const bf16*)(ws + WS_W_GU) + (size_t)l * NGU * DM, MTOK, NGU, DM}; pg8::StaticOrder S; S.init(MTOK, NGU, G, (int)blockIdx.x);
            pg8::EpiSwiGLU E{H, DFF};
            pg8::gemm_phase<pg8::EpiSwiGLU, pg8::StaticOrder, true, true>(lds, g, S, E);
            SEAM(pb + 6);
        }
        if (IN(pb + 7)) REPEAT(REP_GDN) {
            pg8::Gemm g{H, (const bf16*)(ws + WS_W_DN) + (size_t)l * DM * DFF, MTOK, DM, DFF}; pg8::StaticOrder S; S.init(MTOK, DM, G, (int)blockIdx.x);
            pg8::EpiResid E{X, Z, DM, ALPHA};
            pg8::gemm_phase<pg8::EpiResid, pg8::StaticOrder, true, true>(lds, g, S, E);
            SEAM(pb + 7);
        }
        if (IN(pb + 8)) REPEAT(REP_LN) { ln_phase(Z, p.ln_g + (size_t)(2 * l + 1) * DM, p.ln_b + (size_t)(2 * l + 1) * DM, (l == DEPTH - 1) ? p.out : X, XB, gw, NGW, lane); SEAM(pb + 8); }
    }
#undef IN
#undef SEAM
}

#ifndef MK_PER_PHASE
#define MK_PER_PHASE 0
#endif
extern "C" void kernel_launch(void* const* d_in, const int* in_sizes, int n_in, void* d_out, int out_size, void* d_ws, size_t ws_size, hipStream_t stream) {
    static int grid = 0;
    if (grid == 0) {
        if (n_in != 12 || in_sizes[0] != MTOK * DM || out_size != MTOK * DM || ws_size < WS_END) {
            fprintf(stderr, "kernel_launch: unexpected shapes (n_in %d, in0 %d, out %d, ws %zu < %zu?); nothing launched\n", n_in, n_in > 0 ? in_sizes[0] : -1, out_size, ws_size, (size_t)WS_END); grid = -1; return; }
        int dev = 0, cus = 0, per_cu = 0;
        if (hipGetDevice(&dev) != hipSuccess || hipDeviceGetAttribute(&cus, hipDeviceAttributeMultiprocessorCount, dev) != hipSuccess) { grid = -1; return; }
        if (hipFuncSetAttribute((const void*)fwd_kernel, hipFuncAttributeMaxDynamicSharedMemorySize, LDS_BYTES) != hipSuccess) { fprintf(stderr, "kernel_launch: hipFuncSetAttribute failed\n"); grid = -1; return; }
        if (hipOccupancyMaxActiveBlocksPerMultiprocessor(&per_cu, (const void*)fwd_kernel, NWAVES * 64, LDS_BYTES) != hipSuccess || per_cu < 1)
            fprintf(stderr, "kernel_launch: note: occupancy query reports %d workgroups per CU\n", per_cu);
        (void)hipGetLastError();
        grid = cus;
    }
    if (grid < 0) return;
    if (hipMemsetAsync((char*)d_ws + WS_CTL, 0, CTL_ZERO_BYTES, stream) != hipSuccess) { fprintf(stderr, "kernel_launch: hipMemsetAsync failed\n"); return; }
    Params a{};
    a.x = (const float*)d_in[0]; a.a_w_in = (const float*)d_in[1]; a.a_sinks = (const float*)d_in[2]; a.a_w_out = (const float*)d_in[3];
    a.b_w_in = (const float*)d_in[4]; a.b_w_out = (const float*)d_in[5]; a.c_w_in = (const float*)d_in[6]; a.c_w_out = (const float*)d_in[7];
    a.ln_g = (const float*)d_in[8]; a.ln_b = (const float*)d_in[9]; a.w_gu = (const float*)d_in[10]; a.w_dn = (const float*)d_in[11];
    a.out = (float*)d_out; a.ws = (unsigned char*)d_ws; a.pad = 0;
#if MK_PER_PHASE
    int li = 0;
    for (int k = 0; k < NPH; ++k) { if (!phase_exists(k)) continue; a.ph_lo = k; a.ph_hi = k + 1; a.li = li++;
        hipLaunchKernelGGL(fwd_kernel, dim3(grid), dim3(NWAVES * 64), LDS_BYTES, stream, a); }
#else
    a.ph_lo = 0; a.ph_hi = NPH; a.li = 0;
    hipLaunchKernelGGL(fwd_kernel, dim3(grid), dim3(NWAVES * 64), LDS_BYTES, stream, a);
#endif
    const hipError_t le = hipPeekAtLastError();
    if (le != hipSuccess) fprintf(stderr, "kernel_launch: launch failed: %s\n", hipGetErrorName(le));
}
```

```cpp
#include <hip/hip_runtime.h>
#include <cstdio>
#include <cstdint>
namespace pg8 {
#define PG8_LAS __attribute__((address_space(3)))
typedef unsigned short bf16_t;
typedef short bf16x8 __attribute__((ext_vector_type(8)));
typedef float f32x4 __attribute__((ext_vector_type(4)));
typedef unsigned u32x4 __attribute__((ext_vector_type(4)));
constexpr int BM = 256, BK = 64, HALF = 128, HTB = HALF * BK * 2  , STAGE_BYTES = 8 * HTB, NXCD = 8, WGM = 8;

__host__ __device__ __forceinline__ int lds_byte(int r, int c) { const int st = (r >> 4) * 2 + (c >> 5), rr = r & 15, cc = c & 31, ob = rr * 64 + cc * 2; return st * 1024 + (ob ^ (((ob >> 9) & 1) << 5)); }
__host__ __device__ __forceinline__ void stage_rc(int b, int& R, int& C) { const int st = b / 1024, sb = b % 1024, swz = sb ^ (((sb >> 9) & 1) << 5); R = (st >> 1) * 16 + swz / 64; C = (st & 1) * 32 + (swz % 64) / 2; }
__host__ __device__ __forceinline__ int perm32(int rho) { const int n = rho >> 4, i = rho & 15; return 8 * (i >> 2) + 4 * n + (i & 3); }

struct Unit { int pm, pn; };
struct Gemm { const bf16_t* A; const bf16_t* Bt; int M, N, K; };

struct StaticOrder {
    int nM, nN, nwg, G, c;
    __host__ __device__ void init(int M, int N, int G_, int c_) { nM = M / BM; nN = N / BM; nwg = nM * nN; G = G_; c = c_; }
    __host__ __device__ bool next(int i, Unit& u) const {
        const long L = (long)i * G + c; if (L >= nwg) return false;
        int wgid = (int)L; { const int q = nwg / NXCD, r = nwg % NXCD, xcd = wgid % NXCD, off = wgid / NXCD; wgid = (xcd < r ? xcd * (q + 1) : r * (q + 1) + (xcd - r) * q) + off; }
        const int nig = WGM * nN, gid = wgid / nig, fm = gid * WGM, gsz = (nM - fm) < WGM ? (nM - fm) : WGM;
        u.pm = fm + ((wgid % nig) % gsz); u.pn = (wgid % nig) / gsz; return true;
    }
    __device__ __forceinline__ void a_ready(const Unit&) const {}
    __device__ __forceinline__ void done(const Unit&) const {}
};


__device__ __forceinline__ unsigned cvt_pk_bf16(float lo, float hi) { unsigned r; asm volatile("v_cvt_pk_bf16_f32 %0, %1, %2" : "=v"(r) : "v"(lo), "v"(hi)); return r; }
typedef int v8i_t __attribute__((ext_vector_type(8)));
__device__ __forceinline__ v8i_t pg8_cat8(bf16x8 a, bf16x8 b) { typedef int v4i_t __attribute__((ext_vector_type(4))); const v4i_t x = __builtin_bit_cast(v4i_t, a), y = __builtin_bit_cast(v4i_t, b); return (v8i_t){x[0], x[1], x[2], x[3], y[0], y[1], y[2], y[3]}; }
__device__ __forceinline__ float clamp8(float x) { return fminf(fmaxf(x, -448.f), 448.f); }
__device__ __forceinline__ unsigned pack_fp8x4(float a, float b, float c, float d) { int r = __builtin_amdgcn_cvt_pk_fp8_f32(clamp8(a), clamp8(b), 0, false); r = __builtin_amdgcn_cvt_pk_fp8_f32(clamp8(c), clamp8(d), r, true); return (unsigned)r; }

struct EpiQKV {
    static constexpr bool PERM = true, AFTER_DRAIN = false;
    bf16_t* O; int ldc; int qmod, qlim; float qscale;
    __device__ __forceinline__ void operator()(const f32x4 (&acc)[2][2][4][2], const Unit& u, int wr, int wc, int fr, int fq) const {
        const int row0 = u.pm * BM + wr * 64 + fr; const int colt = u.pn * BM;
        const float sc = ((colt % qmod) < qlim) ? qscale : 1.f;
        const int col0 = colt + wc * 32 + 8 * fq;
#pragma unroll
        for (int ai = 0; ai < 2; ++ai)
#pragma unroll
            for (int m = 0; m < 4; ++m) { bf16_t* rowp = O + (size_t)(row0 + ai * HALF + m * 16) * ldc + col0;
#pragma unroll
                for (int bj = 0; bj < 2; ++bj) { f32x4 v0 = acc[ai][bj][m][0] * sc, v1 = acc[ai][bj][m][1] * sc;
                    u32x4 w; w.x = cvt_pk_bf16(v0[0], v0[1]); w.y = cvt_pk_bf16(v0[2], v0[3]); w.z = cvt_pk_bf16(v1[0], v1[1]); w.w = cvt_pk_bf16(v1[2], v1[3]);
                    *(u32x4*)(rowp + bj * HALF) = w; } }
    }
};
template <bool OUT8> struct EpiSwiGLU {
    static constexpr bool PERM = true, AFTER_DRAIN = false;
    bf16_t* Hh; unsigned char* H8; int ldc; float inv, sh;
    __device__ __forceinline__ float sg(float g, float uu) const { g *= inv; const float e = __builtin_amdgcn_exp2f(g * -1.4426950408889634f); return g * __builtin_amdgcn_rcpf(1.0f + e) * (uu * inv); }
    __device__ __forceinline__ void operator()(const f32x4 (&acc)[2][2][4][2], const Unit& u, int wr, int wc, int fr, int fq) const {
        const int row0 = u.pm * BM + wr * 64 + fr; const int col0 = u.pn * HALF + wc * 32 + 8 * fq;
#pragma unroll
        for (int ai = 0; ai < 2; ++ai)
#pragma unroll
            for (int m = 0; m < 4; ++m) { const size_t off = (size_t)(row0 + ai * HALF + m * 16) * ldc + col0;
                const f32x4 g0 = acc[ai][0][m][0], g1 = acc[ai][0][m][1], u0 = acc[ai][1][m][0], u1 = acc[ai][1][m][1];
                if constexpr (OUT8) {
                    const unsigned lo = pack_fp8x4(sg(g0[0], u0[0]) * sh, sg(g0[1], u0[1]) * sh, sg(g0[2], u0[2]) * sh, sg(g0[3], u0[3]) * sh);
                    const unsigned hi = pack_fp8x4(sg(g1[0], u1[0]) * sh, sg(g1[1], u1[1]) * sh, sg(g1[2], u1[2]) * sh, sg(g1[3], u1[3]) * sh);
                    *(unsigned long long*)(H8 + off) = (unsigned long long)lo | ((unsigned long long)hi << 32);
                } else {
                    u32x4 w; w.x = cvt_pk_bf16(sg(g0[0], u0[0]), sg(g0[1], u0[1])); w.y = cvt_pk_bf16(sg(g0[2], u0[2]), sg(g0[3], u0[3]));
                    w.z = cvt_pk_bf16(sg(g1[0], u1[0]), sg(g1[1], u1[1])); w.w = cvt_pk_bf16(sg(g1[2], u1[2]), sg(g1[3], u1[3]));
                    *(u32x4*)(Hh + off) = w; } }
    }
};
struct EpiResid {
    static constexpr bool PERM = false, AFTER_DRAIN = false;
    const float* base; float* out; int ldc; float alpha, ascale;
    __device__ __forceinline__ void operator()(const f32x4 (&acc)[2][2][4][2], const Unit& u, int wr, int wc, int fr, int fq) const {
        const int row0 = u.pm * BM + wr * 64 + fr, col0 = u.pn * BM + wc * 32 + 4 * fq;
#pragma unroll
        for (int ai = 0; ai < 2; ++ai)
#pragma unroll
            for (int m = 0; m < 4; ++m) { const size_t off = (size_t)(row0 + ai * HALF + m * 16) * ldc + col0;
#pragma unroll
                for (int bj = 0; bj < 2; ++bj)
#pragma unroll
                    for (int n = 0; n < 2; ++n) { const f32x4 bs = *(const f32x4*)(base + off + bj * HALF + n * 16); *(f32x4*)(out + off + bj * HALF + n * 16) = bs * alpha + acc[ai][bj][m][n] * ascale; }
                asm volatile("" ::: "memory"); }
    }
};

template <class Epi, class Sched, bool ALIGN_EPI = false, bool SP2 = false, bool FP8 = false>
__device__ __forceinline__ void gemm_phase(PG8_LAS unsigned char* lds, const Gemm g, const Sched& S, const Epi& E) {
    int tid_ = threadIdx.x; asm volatile("" : "+v"(tid_));
    const int tid = tid_, wid = __builtin_amdgcn_readfirstlane(tid >> 6), lane = tid & 63, wr = wid >> 2, wc = wid & 3, fr = lane & 15, fq = lane >> 4;
    const int K = g.K, nt = K / BK;
    int sc1_ = 0x7f7f7f7f; asm volatile("" : "+v"(sc1_));
    unsigned voffA[2], voffB[2];
#pragma unroll
    for (int i = 0; i < 2; ++i) { int R, C; stage_rc(tid * 16 + i * 8192, R, C); const int Rb = Epi::PERM ? ((R & ~31) + perm32(R & 31)) : R;
        voffA[i] = (unsigned)(R * K + C) * 2u; voffB[i] = (unsigned)(Rb * K + C) * 2u; }
    const size_t kstep = (size_t)(BK * 2);
    const size_t hstep = (size_t)HALF * K * 2;
    const size_t tstep = 2 * hstep;
    const unsigned ldsw = (unsigned)wid * 1024u;
    const int aoff = lds_byte(wr * 64 + fr, fq * 8), boff = lds_byte(wc * 32 + fr, fq * 8);
#define PG8_SA(b, h) (((b) * 2 + (h)) * HTB)
#define PG8_SB(b, h) ((4 + (b) * 2 + (h)) * HTB)
#define PG8_STAGE(bufoff, gbase, voff) do { _Pragma("unroll") for (int _i = 0; _i < 2; ++_i) \
        __builtin_amdgcn_global_load_lds((const unsigned*)((const char*)(gbase) + (voff)[_i]), (PG8_LAS unsigned*)(lds + (bufoff) + ldsw + _i * 8192), 16, 0, 0); } while (0)
#define PG8_LDA(dst, b, h) do { _Pragma("unroll") for (int m = 0; m < 4; ++m) _Pragma("unroll") for (int k = 0; k < 2; ++k) dst[m][k] = *(const PG8_LAS bf16x8*)(lds + PG8_SA(b, h) + aoff + m * 2048 + k * 1024); } while (0)
#define PG8_LDB(dst, b, h) do { _Pragma("unroll") for (int n = 0; n < 2; ++n) _Pragma("unroll") for (int k = 0; k < 2; ++k) dst[n][k] = *(const PG8_LAS bf16x8*)(lds + PG8_SB(b, h) + boff + n * 2048 + k * 1024); } while (0)
#define PG8_MMA_ASM(CONS, ai, bj, At, Bt) do { __builtin_amdgcn_s_setprio(1); \
        if constexpr (FP8) { _Pragma("unroll") for (int m = 0; m < 4; ++m) _Pragma("unroll") for (int n = 0; n < 2; ++n) \
            asm volatile("v_mfma_scale_f32_16x16x128_f8f6f4 %0, %1, %2, %0, %3, %3 op_sel_hi:[0,0,0]" : CONS(acc[ai][bj][m][n]) : "v"(pg8_cat8(Bt[n][0], Bt[n][1])), "v"(pg8_cat8(At[m][0], At[m][1])), "v"(sc1_)); } \
        else { _Pragma("unroll") for (int m = 0; m < 4; ++m) _Pragma("unroll") for (int n = 0; n < 2; ++n) _Pragma("unroll") for (int k = 0; k < 2; ++k) \
            acc[ai][bj][m][n] = __builtin_amdgcn_mfma_f32_16x16x32_bf16(Bt[n][k], At[m][k], acc[ai][bj][m][n], 0, 0, 0); } \
        __builtin_amdgcn_s_setprio(0); } while (0)
#define PG8_MMA_0(bj, At, Bt) PG8_MMA_ASM("+v", 0, bj, At, Bt)
#define PG8_MMA_1(bj, At, Bt) PG8_MMA_ASM("+v", 1, bj, At, Bt)
#define PG8_MMA(ai, bj, At, Bt) PG8_MMA_##ai(bj, At, Bt)
#define PG8_WAIT_V(n) asm volatile("s_waitcnt vmcnt(" #n ")" ::: "memory")
#define PG8_WAIT_L(n) asm volatile("s_waitcnt lgkmcnt(" #n ")" ::: "memory")
#define PG8_BAR __builtin_amdgcn_s_barrier()
#define PG8_SCHED __builtin_amdgcn_sched_barrier(0)
    Unit cur, nxt; int ui = 0;
    if (!S.next(0, cur)) return;
    f32x4 acc[2][2][4][2];
#pragma unroll
    for (int a = 0; a < 2; ++a)
#pragma unroll
        for (int b = 0; b < 2; ++b)
#pragma unroll
            for (int m = 0; m < 4; ++m)
#pragma unroll
                for (int n = 0; n < 2; ++n) acc[a][b][m][n] = (f32x4){0.f, 0.f, 0.f, 0.f};
    bf16x8 At[4][2], B0[2][2], B1[2][2];
    const char* cA = (const char*)g.A + (size_t)cur.pm * tstep; const char* cB = (const char*)g.Bt + (size_t)cur.pn * tstep;
    S.a_ready(cur);
    if constexpr (SP2) {
        PG8_STAGE(PG8_SB(0, 0), cB, voffB); PG8_STAGE(PG8_SB(0, 1), cB + hstep, voffB); PG8_STAGE(PG8_SA(0, 0), cA, voffA); PG8_STAGE(PG8_SA(0, 1), cA + hstep, voffA);
        if (wr == 1) PG8_BAR;
        PG8_WAIT_V(2); PG8_BAR;
        PG8_STAGE(PG8_SB(1, 0), cB + kstep, voffB); PG8_STAGE(PG8_SA(1, 0), cA + kstep, voffA); PG8_STAGE(PG8_SB(1, 1), cB + hstep + kstep, voffB);
        PG8_WAIT_V(6); PG8_BAR;
    } else {
        PG8_STAGE(PG8_SB(0, 0), cB, voffB); PG8_STAGE(PG8_SA(0, 0), cA, voffA); PG8_STAGE(PG8_SB(0, 1), cB + hstep, voffB); PG8_STAGE(PG8_SA(0, 1), cA + hstep, voffA);
        if (wr == 1) PG8_BAR;
        PG8_WAIT_V(4); PG8_BAR;
        PG8_STAGE(PG8_SB(1, 0), cB + kstep, voffB); PG8_STAGE(PG8_SA(1, 0), cA + kstep, voffA); PG8_STAGE(PG8_SB(1, 1), cB + hstep + kstep, voffB);
        PG8_WAIT_V(6); PG8_BAR;
    }
    for (;;) {
        const bool has_next = S.next(ui + 1, nxt);
        const char* nA = has_next ? (const char*)g.A + (size_t)nxt.pm * tstep : cA; const char* nB = has_next ? (const char*)g.Bt + (size_t)nxt.pn * tstep : cB;
        for (int t = 0; t < nt; t += 2) {
            const bool last = (t == nt - 2);
            const char* a1 = cA + (size_t)(t + 1) * kstep;
            const char* a2 = last ? nA : cA + (size_t)(t + 2) * kstep; const char* b2 = last ? nB : cB + (size_t)(t + 2) * kstep;
            const char* a3 = a2 + kstep; const char* b3 = b2 + kstep;
            if (last && has_next) S.a_ready(nxt);
            if constexpr (SP2) {
            PG8_LDB(B0, 0, 0); PG8_LDB(B1, 0, 1); PG8_SCHED; PG8_LDA(At, 0, 0); PG8_STAGE(PG8_SA(1, 1), a1 + hstep, voffA);
            PG8_WAIT_V(8); PG8_WAIT_L(0); PG8_BAR; PG8_MMA(0, 0, At, B0); PG8_MMA(0, 1, At, B1); PG8_BAR; PG8_SCHED;
            PG8_LDA(At, 0, 1); PG8_STAGE(PG8_SB(0, 0), b2, voffB); PG8_STAGE(PG8_SB(0, 1), b2 + hstep, voffB); PG8_STAGE(PG8_SA(0, 0), a2, voffA);
            PG8_WAIT_V(8); PG8_WAIT_L(0); PG8_BAR; PG8_MMA(1, 0, At, B0); PG8_MMA(1, 1, At, B1); PG8_BAR; PG8_SCHED;
            PG8_LDB(B0, 1, 0); PG8_LDB(B1, 1, 1); PG8_SCHED; PG8_LDA(At, 1, 0); PG8_STAGE(PG8_SA(0, 1), a2 + hstep, voffA);
            PG8_WAIT_V(8); PG8_WAIT_L(0); PG8_BAR; PG8_MMA(0, 0, At, B0); PG8_MMA(0, 1, At, B1); PG8_BAR; PG8_SCHED;
            PG8_LDA(At, 1, 1); PG8_STAGE(PG8_SB(1, 0), b3, voffB); PG8_STAGE(PG8_SB(1, 1), b3 + hstep, voffB); PG8_STAGE(PG8_SA(1, 0), a3, voffA);
            PG8_WAIT_V(8); PG8_WAIT_L(0); PG8_BAR; PG8_MMA(1, 0, At, B0); PG8_MMA(1, 1, At, B1); PG8_BAR; PG8_SCHED;
            } else {
            PG8_LDB(B0, 0, 0); PG8_SCHED; PG8_LDA(At, 0, 0); PG8_STAGE(PG8_SA(1, 1), a1 + hstep, voffA);
            PG8_WAIT_L(8); PG8_BAR; PG8_WAIT_L(0); PG8_MMA(0, 0, At, B0); PG8_BAR; PG8_SCHED;
            PG8_LDB(B1, 0, 1); PG8_STAGE(PG8_SB(0, 0), b2, voffB);
            PG8_BAR; PG8_WAIT_L(0); PG8_MMA(0, 1, At, B1); PG8_BAR;
            PG8_LDA(At, 0, 1); PG8_STAGE(PG8_SA(0, 0), a2, voffA);
            PG8_BAR; PG8_WAIT_L(0); PG8_MMA(1, 0, At, B0); PG8_BAR; PG8_SCHED;
            PG8_STAGE(PG8_SB(0, 1), b2 + hstep, voffB);
            PG8_WAIT_V(6); PG8_BAR; PG8_MMA(1, 1, At, B1); PG8_BAR;
            PG8_LDB(B0, 1, 0); PG8_SCHED; PG8_LDA(At, 1, 0); PG8_STAGE(PG8_SA(0, 1), a2 + hstep, voffA);
            PG8_WAIT_L(8); PG8_BAR; PG8_WAIT_L(0); PG8_MMA(0, 0, At, B0); PG8_BAR; PG8_SCHED;
            PG8_LDB(B1, 1, 1); PG8_STAGE(PG8_SB(1, 0), b3, voffB);
            PG8_BAR; PG8_WAIT_L(0); PG8_MMA(0, 1, At, B1); PG8_BAR;
            PG8_LDA(At, 1, 1); PG8_STAGE(PG8_SA(1, 0), a3, voffA);
            PG8_BAR; PG8_WAIT_L(0); PG8_MMA(1, 0, At, B0); PG8_BAR; PG8_SCHED;
            PG8_STAGE(PG8_SB(1, 1), b3 + hstep, voffB);
            PG8_WAIT_V(6); PG8_BAR; PG8_MMA(1, 1, At, B1); PG8_BAR;
            }
        }
        if constexpr (ALIGN_EPI) { if (wr == 0) PG8_BAR; }
        if constexpr (FP8) {
            __builtin_amdgcn_sched_barrier(0);
#define PG8_PIN8(a, b) "+v"(acc[a][b][0][0]), "+v"(acc[a][b][0][1]), "+v"(acc[a][b][1][0]), "+v"(acc[a][b][1][1]), "+v"(acc[a][b][2][0]), "+v"(acc[a][b][2][1]), "+v"(acc[a][b][3][0]), "+v"(acc[a][b][3][1])
            asm volatile("s_nop 15\n\ts_nop 15" : PG8_PIN8(0, 0), PG8_PIN8(0, 1));
            asm volatile("s_nop 1" : PG8_PIN8(1, 0), PG8_PIN8(1, 1));
#undef PG8_PIN8
            __builtin_amdgcn_sched_barrier(0); }
        if constexpr (!Epi::AFTER_DRAIN) { int t2_ = threadIdx.x; asm volatile("" : "+v"(t2_));
            const int l2_ = t2_ & 63; E(acc, cur, wr, wc, l2_ & 15, l2_ >> 4); S.done(cur); }
        if (!has_next) break;
#pragma unroll
        for (int a = 0; a < 2; ++a)
#pragma unroll
            for (int b = 0; b < 2; ++b)
#pragma unroll
                for (int m = 0; m < 4; ++m)
#pragma unroll
                    for (int n = 0; n < 2; ++n) acc[a][b][m][n] = (f32x4){0.f, 0.f, 0.f, 0.f};
        cur = nxt; cA = nA; cB = nB; ++ui;
        if constexpr (ALIGN_EPI) { if (wr == 1) PG8_BAR; }
    }
    PG8_WAIT_V(0);
    if constexpr (!ALIGN_EPI) { if (wr == 0) PG8_BAR; }
    PG8_BAR;
    if constexpr (Epi::AFTER_DRAIN) { E.fused(acc, cur, wr, wc, fr, fq, lds, wid, lane); S.done(cur); }
#undef PG8_SA
#undef PG8_SB
#undef PG8_STAGE
#undef PG8_LDA
#undef PG8_LDB
#undef PG8_MMA
#undef PG8_MMA_0
#undef PG8_MMA_1
#undef PG8_MMA_ASM
#undef PG8_WAIT_V
#undef PG8_WAIT_L
#undef PG8_BAR
#undef PG8_SCHED
}
}
#define GAS __attribute__((address_space(1)))
#define LAS __attribute__((address_space(3)))
typedef unsigned short bf16;
typedef unsigned v4u __attribute__((ext_vector_type(4)));
typedef float f32x4 __attribute__((ext_vector_type(4)));
typedef short bf16x8 __attribute__((ext_vector_type(8)));
typedef GAS unsigned gu32;
typedef GAS unsigned long long gu64;
#define RLX_AGENT __ATOMIC_RELAXED, __HIP_MEMORY_SCOPE_AGENT
#define LDS_WAIT() asm volatile("s_waitcnt lgkmcnt(0)" ::: "memory")
#define VM_WAIT() asm volatile("s_waitcnt vmcnt(0)" ::: "memory")
__device__ __forceinline__ unsigned long long rt() { return __builtin_amdgcn_s_memrealtime(); }
__device__ __forceinline__ unsigned f2bf(float f) { unsigned u = __builtin_bit_cast(unsigned, f); return (u + 0x7fffu + ((u >> 16) & 1u)) >> 16; }
__device__ __forceinline__ unsigned pk2(float lo, float hi) { return f2bf(lo) | (f2bf(hi) << 16); }

#define XB_TMO      128
#define XB_XCNT(j)  (256  + 64 * (j))
#define XB_XSUB(j)  (1280 + 64 * (j))
#define XB_XGEN(j)  (2304 + 64 * (j))
#define XB_TOP      3328
#define XB_TOPGEN   3392
#define XCD_BAR_WORDS 3456
#define XB_SPIN_CAP (1u << 18)

__device__ __forceinline__ unsigned xb_ld(unsigned* p)              { return __hip_atomic_load(p, __ATOMIC_RELAXED, __HIP_MEMORY_SCOPE_AGENT); }
__device__ __forceinline__ unsigned xb_add(unsigned* p, unsigned v) { return __hip_atomic_fetch_add(p, v, __ATOMIC_RELAXED, __HIP_MEMORY_SCOPE_AGENT); }
__device__ __forceinline__ unsigned xb_xcc_id() { return (unsigned)__builtin_amdgcn_s_getreg((3 << 11) | 20) & 0xFu; }
#define XB_SPIN(cond, bar) do { unsigned _sp = 0; while (cond) { __builtin_amdgcn_s_sleep(1); \
    if ((++_sp & 255u) == 0u) { if (xb_ld(&(bar)[XB_TMO])) break; if (_sp > XB_SPIN_CAP) { atomicAdd(&(bar)[XB_TMO], 1u); break; } } } } while (0)

struct XcdBarrier {
    unsigned* bar; unsigned x;
    volatile LAS unsigned* st;
};

__device__ __forceinline__ XcdBarrier xcd_barrier_post(unsigned* bar, volatile LAS unsigned* st) {
    XcdBarrier b; b.bar = bar; b.x = xb_xcc_id(); b.st = st;
    if (threadIdx.x == 0) (void)xb_add(&bar[XB_XCNT(b.x)], 1u);
    return b;
}
__device__ __forceinline__ void xcd_barrier_complete(unsigned* bar, unsigned x, unsigned& nloc, unsigned& nx) {
    const unsigned G = gridDim.x * gridDim.y * gridDim.z;
    unsigned sum, cnt, mine, sp = 0u;
    for (;;) {
        sum = 0u; cnt = 0u; mine = 0u;
#pragma unroll
        for (unsigned j = 0; j < 16; ++j) { const unsigned c = xb_ld(&bar[XB_XCNT(j)]); sum += c; cnt += (c > 0u) ? 1u : 0u; mine = (j == x) ? c : mine; }
        if (sum == G) break;
        __builtin_amdgcn_s_sleep(1);
        if ((++sp & 255u) == 0u) { if (xb_ld(&bar[XB_TMO])) break; if (sp > XB_SPIN_CAP) { atomicAdd(&bar[XB_TMO], 1u); break; } }
    }
    nloc = mine > 0u ? mine : 1u; nx = cnt > 0u ? cnt : 1u;
}

__device__ __forceinline__ void xcd_barrier(const XcdBarrier& b) {
    asm volatile("s_waitcnt vmcnt(0)" ::: "memory");
    __syncthreads();
    if (threadIdx.x == 0) {
        unsigned* bar = b.bar;
        __builtin_amdgcn_s_waitcnt(0);
        unsigned nloc = b.st[0], nx = b.st[1];
        if (nloc == 0u) { xcd_barrier_complete(bar, b.x, nloc, nx); b.st[0] = nloc; b.st[1] = nx; }
        const unsigned old = xb_add(&bar[XB_XSUB(b.x)], 1u);
        const unsigned gen = old / nloc;
        if (old + 1u == (gen + 1u) * nloc) {
            __builtin_amdgcn_fence(__ATOMIC_RELEASE, "agent");
            asm volatile("s_waitcnt vmcnt(0)" ::: "memory");
            const unsigned og = xb_add(&bar[XB_TOP], 1u);
            const unsigned tg = og / nx;
            if (og + 1u == (tg + 1u) * nx) xb_add(&bar[XB_TOPGEN], 1u);
            else XB_SPIN(xb_ld(&bar[XB_TOPGEN]) == tg, bar);
            __builtin_amdgcn_fence(__ATOMIC_ACQUIRE, "agent");
            xb_add(&bar[XB_XGEN(b.x)], 1u);
            asm volatile("s_waitcnt vmcnt(0)" ::: "memory");
        } else {
            XB_SPIN(xb_ld(&bar[XB_XGEN(b.x)]) == gen, bar);
            __builtin_amdgcn_fence(__ATOMIC_ACQUIRE, "agent");
            asm volatile("s_waitcnt vmcnt(0)" ::: "memory");
        }
    }
    __syncthreads();
}

constexpr int BATCH = 2, SEQ = 4096, DM = 2048, MTOK = BATCH * SEQ, DEPTH = 4;
constexpr int NH = 32, NKV = 4, HD = 64, QD = 2048, KVD = 256;
constexpr int A_IN = 2560, B_IN = 7680, C_IN = 3664, C_INP = 3840;
constexpr int DFF = 5632, NGU = 2 * DFF;
constexpr int IDXH = 16, IDXD = 64, TOPK = 256;
constexpr int C_QI = 2560, C_KI = 3584, C_WI = 3648;
constexpr float ALPHA = 1.6817928305074290f;
constexpr float LN_EPS = 1e-5f;
constexpr float LOG2E = 1.4426950408889634f;
constexpr float C2 = 0.125f * LOG2E;
#ifndef USE_FP8_GU
#define USE_FP8_GU 1
#endif
#ifndef USE_FP8_DN
#define USE_FP8_DN 1
#endif
constexpr float S_X8 = 16.f, S_WGU8 = 512.f, S_H8 = 8.f, S_WDN8 = 4096.f;

constexpr size_t MiB = 1u << 20;
constexpr size_t WS_CTL = 0, CTL_ZERO_BYTES = 1 * MiB;
constexpr size_t WS_W_AIN = 2 * MiB;
constexpr size_t WS_W_AOUT = WS_W_AIN + 20 * MiB;
constexpr size_t WS_W_BIN = WS_W_AOUT + 16 * MiB;
constexpr size_t WS_W_BOUT = WS_W_BIN + 30 * MiB;
constexpr size_t WS_W_CIN = WS_W_BOUT + 8 * MiB;
constexpr size_t WS_W_COUT = WS_W_CIN + 15 * MiB;
constexpr size_t WS_W_GU = WS_W_COUT + 8 * MiB;
constexpr size_t WS_W_DN = WS_W_GU + 176 * MiB;
constexpr size_t WS_X = WS_W_DN + 88 * MiB;
constexpr size_t WS_XB = WS_X + 64 * MiB;
constexpr size_t WS_Z = WS_XB + 32 * MiB;
constexpr size_t WS_O = WS_Z + 64 * MiB;
constexpr size_t WS_MASK = WS_O + 32 * MiB;
constexpr size_t WS_QKV = WS_MASK + 4 * MiB;
constexpr size_t WS_H = WS_QKV + 120 * MiB;
constexpr size_t WS_SC = WS_H;
constexpr size_t WS_XB8 = WS_H + 128 * MiB;
constexpr size_t WS_END = WS_XB8 + 16 * MiB;
constexpr int CW_BAR = 4096;

constexpr int RING_BYTES = 131072;
constexpr int LDSCTL_OFF = RING_BYTES, MISC_OFF = LDSCTL_OFF + 320;
constexpr int LDS_BYTES = 147456;
constexpr int NWAVES = 8;

typedef unsigned long long u64;
#define OPAQUE_V(x) asm volatile("" : "+v"(x))
#define OPAQUE_S(x) asm volatile("" : "+s"(x))

__device__ __forceinline__ float bf_lo(unsigned u) { return __uint_as_float(u << 16); }
__device__ __forceinline__ float bf_hi(unsigned u) { return __uint_as_float(u & 0xffff0000u); }
__device__ __forceinline__ float wave_sum(float v) {
#pragma unroll
    for (int o = 1; o < 64; o <<= 1) v += __shfl_xor(v, o);
    return v;
}
__device__ __forceinline__ unsigned wave_sum_u(unsigned v) {
#pragma unroll
    for (int o = 1; o < 64; o <<= 1) v += (unsigned)__shfl_xor((int)v, o);
    return v;
}

__device__ __forceinline__ void conv_item(const float* W, int K, int N, int Npad, bf16* WT, int mode, LAS float* scr, int item, int lane) {
    OPAQUE_V(lane); OPAQUE_S(N);
    const int nblk = Npad / 64, kb = item / nblk, nb = item % nblk, k0 = 64 * kb, n0 = 64 * nb;
    const int ncol = n0 + lane; const bool nok = ncol < N;
    const float* wp = W + (size_t)k0 * N + ncol;
    float wreg[64];
#pragma unroll
    for (int i = 0; i < 64; ++i) wreg[i] = nok ? wp[(size_t)i * N] : 0.f;
#pragma unroll
    for (int i = 0; i < 64; ++i) scr[i * 64 + (lane ^ (i & 31))] = wreg[i];
    LDS_WAIT(); asm volatile("" ::: "memory");
    int row0 = n0;
    if (mode == 1) { if (n0 < DFF) row0 = 256 * (n0 / 128) + (n0 % 128); else { const int c = n0 - DFF; row0 = 256 * (c / 128) + 128 + (c % 128); } }
    const int c = lane & 7, nl = lane >> 3;
#pragma unroll
    for (int j = 0; j < 8; ++j) { const int n = nl + 8 * j; float e[8];
#pragma unroll
        for (int q = 0; q < 8; ++q) e[q] = scr[(8 * c + q) * 64 + (n ^ ((8 * c + q) & 31))];
        v4u o; o.x = pk2(e[0], e[1]); o.y = pk2(e[2], e[3]); o.z = pk2(e[4], e[5]); o.w = pk2(e[6], e[7]);
        *(GAS v4u*)(WT + (size_t)(row0 + n) * K + k0 + 8 * c) = o; }
    LDS_WAIT(); asm volatile("" ::: "memory");
}

__device__ __forceinline__ void conv_item8(const float* W, int K, int N, unsigned char* WT, int mode, float scale, LAS unsigned* scr, int item, int lane) {
    OPAQUE_V(lane); OPAQUE_S(N);
    const int nblk = N / 64, kb = item / nblk, nb = item % nblk, k0 = 128 * kb, n0 = 64 * nb;
    const float* wp = W + (size_t)k0 * N + n0 + lane;
#pragma unroll
    for (int half = 0; half < 2; ++half) {
        float wreg[64];
#pragma unroll
        for (int i = 0; i < 64; ++i) wreg[i] = wp[(size_t)(64 * half + i) * N];
#pragma unroll
        for (int q = 0; q < 16; ++q) scr[lane * 32 + ((16 * half + q) ^ (lane & 31))] = pg8::pack_fp8x4(wreg[4 * q] * scale, wreg[4 * q + 1] * scale, wreg[4 * q + 2] * scale, wreg[4 * q + 3] * scale);
    }
    LDS_WAIT(); asm volatile("" ::: "memory");
    int row0 = n0;
    if (mode == 1) { if (n0 < DFF) row0 = 256 * (n0 / 128) + (n0 % 128); else { const int c = n0 - DFF; row0 = 256 * (c / 128) + 128 + (c % 128); } }
    const int c = lane & 7, nl = lane >> 3;
#pragma unroll
    for (int j = 0; j < 8; ++j) { const int n = nl + 8 * j; v4u o;
        o.x = scr[n * 32 + ((4 * c + 0) ^ (n & 31))]; o.y = scr[n * 32 + ((4 * c + 1) ^ (n & 31))]; o.z = scr[n * 32 + ((4 * c + 2) ^ (n & 31))]; o.w = scr[n * 32 + ((4 * c + 3) ^ (n & 31))];
        *(GAS v4u*)(WT + (size_t)(row0 + n) * K + k0 + 16 * c) = o; }
    LDS_WAIT(); asm volatile("" ::: "memory");
}

struct Params {
    const float* x; const float* a_w_in; const float* a_sinks; const float* a_w_out; const float* b_w_in; const float* b_w_out;
    const float* c_w_in; const float* c_w_out; const float* ln_g; const float* ln_b; const float* w_gu; const float* w_dn;
    float* out; unsigned char* ws;
    int ph_lo, ph_hi, li, pad;
};

__device__ __forceinline__ void prologue_phase(const Params& p, LAS unsigned char* lds, int gw, int NGW, int wave, int lane) {
    OPAQUE_V(lane); OPAQUE_S(gw); OPAQUE_S(wave);
    LAS float* scr = (LAS float*)(lds + wave * 16384);
    unsigned char* ws = p.ws;
    for (int mi = 0; mi < 16; ++mi) {
        const float* W; bf16* WT; int K, N, Npad, mode = 0;
        if (mi < 2)       { W = p.a_w_in + (size_t)mi * DM * A_IN;  WT = (bf16*)(ws + WS_W_AIN) + (size_t)mi * A_IN * DM;  K = DM; N = A_IN; Npad = A_IN; }
        else if (mi < 4)  { W = p.a_w_out + (size_t)(mi - 2) * QD * DM; WT = (bf16*)(ws + WS_W_AOUT) + (size_t)(mi - 2) * DM * QD; K = QD; N = DM; Npad = DM; }
        else if (mi == 4) { W = p.b_w_in;  WT = (bf16*)(ws + WS_W_BIN);  K = DM; N = B_IN; Npad = B_IN; }
        else if (mi == 5) { W = p.b_w_out; WT = (bf16*)(ws + WS_W_BOUT); K = QD; N = DM; Npad = DM; }
        else if (mi == 6) { W = p.c_w_in;  WT = (bf16*)(ws + WS_W_CIN);  K = DM; N = C_IN; Npad = C_INP; }
        else if (mi == 7) { W = p.c_w_out; WT = (bf16*)(ws + WS_W_COUT); K = QD; N = DM; Npad = DM; }
        else if (mi < 12) { W = p.w_gu + (size_t)(mi - 8) * DM * NGU; WT = (bf16*)(ws + WS_W_GU) + (size_t)(mi - 8) * NGU * DM; K = DM; N = NGU; Npad = NGU; mode = 1; }
        else              { W = p.w_dn + (size_t)(mi - 12) * DFF * DM; WT = (bf16*)(ws + WS_W_DN) + (size_t)(mi - 12) * DM * DFF; K = DFF; N = DM; Npad = DM; }
        const bool f8 = (mi >= 8 && mi < 12) ? (USE_FP8_GU != 0) : (mi >= 12 ? (USE_FP8_DN != 0) : false);
        if (f8) { const int items = (K / 128) * (N / 64); const float sc = (mi < 12) ? S_WGU8 : S_WDN8;
            for (int it = gw; it < items; it += NGW) conv_item8(W, K, N, (unsigned char*)WT, mode, sc, (LAS unsigned*)scr, it, lane); }
        else { const int items = (K / 64) * (Npad / 64);
            for (int it = gw; it < items; it += NGW) conv_item(W, K, N, Npad, WT, mode, scr, it, lane); }
    }
    bf16* XB = (bf16*)(ws + WS_XB);
    for (int m = gw; m < MTOK; m += NGW) {
        const GAS f32x4* xr = (const GAS f32x4*)(p.x + (size_t)m * DM) + lane; GAS u64* o8 = (GAS u64*)(XB + (size_t)m * DM) + lane;
#pragma unroll
        for (int j = 0; j < 8; ++j) { const f32x4 v = xr[64 * j]; o8[64 * j] = (u64)pk2(v.x, v.y) | ((u64)pk2(v.z, v.w) << 32); }
    }
}

__device__ __forceinline__ void ln_phase(const float* Z, const float* g, const float* b, float* Xo, bf16* XBo, unsigned char* XB8o, int gw, int NGW, int lane) {
    OPAQUE_V(lane); OPAQUE_S(gw);
    for (int m = gw; m < MTOK; m += NGW) {
        const GAS f32x4* zr = (const GAS f32x4*)(Z + (size_t)m * DM) + lane;
        f32x4 v[8]; float s = 0.f;
#pragma unroll
        for (int j = 0; j < 8; ++j) { v[j] = zr[64 * j]; s += (v[j].x + v[j].y) + (v[j].z + v[j].w); }
        const float mean = wave_sum(s) * (1.f / DM); float s2 = 0.f;
#pragma unroll
        for (int j = 0; j < 8; ++j) { v[j] = v[j] - mean; s2 += (v[j].x * v[j].x + v[j].y * v[j].y) + (v[j].z * v[j].z + v[j].w * v[j].w); }
        const float rstd = 1.f / sqrtf(wave_sum(s2) * (1.f / DM) + LN_EPS);
        GAS f32x4* xo = (GAS f32x4*)(Xo + (size_t)m * DM) + lane; GAS u64* o8 = (GAS u64*)(XBo + (size_t)m * DM) + lane;
#pragma unroll
        for (int j = 0; j < 8; ++j) { const f32x4 gg = ((const f32x4*)g)[lane + 64 * j], bb = ((const f32x4*)b)[lane + 64 * j];
            const f32x4 y = v[j] * rstd * gg + bb; xo[64 * j] = y;
            if (XB8o) ((GAS unsigned*)(XB8o + (size_t)m * DM))[lane + 64 * j] = pg8::pack_fp8x4(y.x * S_X8, y.y * S_X8, y.z * S_X8, y.w * S_X8);
            else o8[64 * j] = (u64)pk2(y.x, y.y) | ((u64)pk2(y.z, y.w) << 32); }
    }
}

__device__ __forceinline__ unsigned fkey(float f) { const unsigned u = __float_as_uint(f); return (u & 0x80000000u) ? ~u : (u | 0x80000000u); }
__device__ __forceinline__ void select_phase(const float* SC, u64* MASK, int gw, int NGW, int lane) {
    OPAQUE_V(lane); OPAQUE_S(gw);
    for (int row = gw; row < MTOK; row += NGW) {
        const int t = row & (SEQ - 1); const int nblk = (t >> 6) + 1;
        const float* sr = SC + (size_t)row * SEQ;
        u64* mrow = MASK + (size_t)row * 64;
        if (t < TOPK) {
            for (int i = 0; i < nblk; ++i) { const u64 bits = __ballot(64 * i + lane <= t); if (lane == 0) mrow[i] = bits; }
            continue;
        }
        unsigned u[64];
#pragma unroll
        for (int i = 0; i < 64; ++i) { const int e = 64 * i + lane; u[i] = 0u; if (i < nblk) { if (e <= t) u[i] = fkey(sr[e]); } }
        unsigned T = 0u;
        for (int bit = 31; bit >= 0; --bit) {
            const unsigned cand = T | (1u << bit); unsigned c = 0u;
#pragma unroll
            for (int i = 0; i < 64; ++i) c += (u[i] >= cand) ? 1u : 0u;
            c = wave_sum_u(c);
            if (c >= (unsigned)TOPK) T = cand;
        }
        unsigned cg = 0u;
#pragma unroll
        for (int i = 0; i < 64; ++i) cg += (u[i] > T) ? 1u : 0u;
        cg = wave_sum_u(cg);
        const unsigned need = (unsigned)TOPK - cg; unsigned run = 0u;
        const u64 ltmask = (lane == 0) ? 0ull : (~0ull >> (64 - lane));
#pragma unroll
        for (int i = 0; i < 64; ++i) {
            if (i < nblk) {
                const bool gt = u[i] > T, eq = u[i] == T; const u64 eqm = __ballot(eq);
                const unsigned rank = run + (unsigned)__popcll(eqm & ltmask);
                const u64 bits = __ballot(gt || (eq && rank < need)); run += (unsigned)__popcll(eqm);
                if (lane == 0) mrow[i] = bits;
            }
        }
    }
}


namespace att {
typedef short bf16x8 __attribute__((ext_vector_type(8)));
typedef float f32x16 __attribute__((ext_vector_type(16)));
typedef short s16x4 __attribute__((ext_vector_type(4)));
typedef short v4i16_t __attribute__((ext_vector_type(4)));
#define ATT_CR(r) (((r) & 3) + 8 * ((r) >> 2))
constexpr float NEG_BIG = -1.0e30f;
constexpr int BUFB = 16384;

__device__ __forceinline__ s16x4 vtr(const LAS unsigned char* p) { return __builtin_bit_cast(s16x4, __builtin_amdgcn_ds_read_tr16_b64_v4i16((LAS v4i16_t*)p)); }
__device__ __forceinline__ float xhalf_max(float v) { auto rr = __builtin_amdgcn_permlane32_swap(__float_as_uint(v), __float_as_uint(v), false, false); return fmaxf(__uint_as_float(rr[0]), __uint_as_float(rr[1])); }
__device__ __forceinline__ float xhalf_sum(float v) { auto rr = __builtin_amdgcn_permlane32_swap(__float_as_uint(v), __float_as_uint(v), false, false); return __uint_as_float(rr[0]) + __uint_as_float(rr[1]); }
__device__ __forceinline__ unsigned cvtpk(float lo, float hi) { typedef float f2 __attribute__((ext_vector_type(2))); typedef __bf16 b2 __attribute__((ext_vector_type(2))); f2 v = {lo, hi}; b2 b = __builtin_convertvector(v, b2); return __builtin_bit_cast(unsigned, b); }

__device__ __forceinline__ void attn_phase(int kind, const bf16* P, int pitch, const float* sinks, const u64* MASK, bf16* Oout, LAS unsigned char* lds, int G) {
    int tid = threadIdx.x; OPAQUE_V(tid);
    const int lane = tid & 63, wave = __builtin_amdgcn_readfirstlane(tid >> 6), l31 = lane & 31, hi = lane >> 5;
    int koff[4];
#pragma unroll
    for (int s = 0; s < 4; ++s) koff[s] = l31 * 128 + (((2 * s + hi) ^ ((l31 >> 1) & 7)) << 4);
    const int q4 = (lane & 15) >> 2, g1 = (lane >> 4) & 1, p4 = lane & 3, fV = (q4 >> 1) & 1;
    int voff[2];
#pragma unroll
    for (int db = 0; db < 2; ++db) voff[db] = 8192 + (4 * hi + q4) * 128 + ((((db ^ fV) << 2) + 2 * g1 + (p4 >> 1)) << 4) + 8 * (p4 & 1);
    const int srow = tid >> 3, spc = tid & 7;
    const int skoff = srow * 128 + ((spc ^ ((srow >> 1) & 7)) << 4);
    const int svoff = 8192 + srow * 128 + ((spc ^ (((srow >> 1) & 1) << 2)) << 4);
    const bool useMask = (kind == 2);
    const int ng = (kind == 1) ? 3 : 1;

    for (int it = 0;; ++it) {
        const int v = it * G + (int)blockIdx.x; if (v >= 1024) break;
        const int combo = v & 7, qq = v >> 3, jq = qq & 31, kq = qq >> 5;
        const int tile = (kq == 0) ? jq : (kq == 1) ? 63 - jq : (kq == 2) ? 64 + jq : 127 - jq;
        const int b = combo >> 2, kvh = combo & 3, h = kvh * 8 + wave;
        const float slope = exp2f(-0.25f * (float)(h + 1)) * LOG2E;
        const int T0 = (kind == 1) ? (512 * (tile >> 4) + (tile & 15)) : 32 * tile;
        const int qstride = (kind == 1) ? 16 : 1;
        const size_t brow = (size_t)b * SEQ;
        const size_t qrow = brow + T0 + l31 * qstride;
        f32x16 O0, O1;
#pragma unroll
        for (int r = 0; r < 16; ++r) { O0[r] = 0.f; O1[r] = 0.f; }
        float m = NEG_BIG, lsum = 0.f;
        if (kind == 0) { m = sinks[h] * LOG2E; lsum = (hi == 0) ? 1.f : 0.f; }

        for (int g = 0; g < ng; ++g) {
            const int dsh = (kind == 1) ? 2 * g : 0, d = 1 << dsh;
            const int W = (kind == 0) ? 128 : (kind == 1) ? 129 : (1 << 20);
            const int qs = qstride >> dsh;
            const int cbase = g * A_IN;
            const int res = T0 & (d - 1), u0 = T0 >> dsh;
            const int uq = u0 + l31 * qs, khi = u0 + 31 * qs;
            int klo = u0 - (W - 1); klo = (klo < 0 ? 0 : klo) & ~31;
            const int nsub = ((khi - klo) >> 5) + 1, nch = (nsub + 1) >> 1;
            const float c1 = slope * (float)d;
            bf16x8 qf[4];
#pragma unroll
            for (int s = 0; s < 4; ++s) qf[s] = *(const GAS bf16x8*)(P + qrow * pitch + cbase + h * HD + 16 * s + 8 * hi);
            const bf16* kcol = P + cbase + QD + kvh * HD + spc * 8;
            v4u kreg, vreg; u64 mw = 0ull, mwn = 0ull;
            { int tok = (klo + srow) * d + res; tok = tok > SEQ - 1 ? SEQ - 1 : tok; const bf16* kp = kcol + (brow + tok) * pitch;
              kreg = *(const GAS v4u*)kp; vreg = *(const GAS v4u*)(kp + KVD);
              if (useMask) mw = MASK[qrow * 64 + (klo >> 6)]; }
            *(LAS v4u*)(lds + skoff) = kreg; *(LAS v4u*)(lds + svoff) = vreg;
            __syncthreads();
            for (int c = 0; c < nch; ++c) {
                const int kidxc = klo + 64 * c; const int bufo = (c & 1) * BUFB;
                if (c + 1 < nch) { int tok = (kidxc + 64 + srow) * d + res; tok = tok > SEQ - 1 ? SEQ - 1 : tok; const bf16* kp = kcol + (brow + tok) * pitch;
                    kreg = *(const GAS v4u*)kp; vreg = *(const GAS v4u*)(kp + KVD);
                    if (useMask) mwn = MASK[qrow * 64 + ((kidxc + 64) >> 6)]; }
#pragma unroll
                for (int sub = 0; sub < 2; ++sub) {
                    if (2 * c + sub < nsub) {
                        const int kidx0 = kidxc + 32 * sub;
                        const int dq = uq - kidx0 - 4 * hi;
                        const float base = c1 * (float)(-dq);
                        f32x16 S;
#pragma unroll
                        for (int r = 0; r < 16; ++r) S[r] = fmaf((float)ATT_CR(r), c1, base);
                        const LAS unsigned char* kb = lds + bufo + sub * 4096;
#pragma unroll
                        for (int s = 0; s < 4; ++s) { const bf16x8 kf = *(const LAS bf16x8*)(kb + koff[s]); S = __builtin_amdgcn_mfma_f32_32x32x16_bf16(kf, qf[s], S, 0, 0, 0); }
                        const bool full = (u0 - (kidx0 + 31) >= 0) && (khi - kidx0 <= W - 1);
                        if (!full) {
#pragma unroll
                            for (int r = 0; r < 16; ++r) { const int dist = dq - ATT_CR(r); if ((unsigned)dist >= (unsigned)W) S[r] = NEG_BIG; }
                        }
                        if (useMask) { const unsigned mws = (unsigned)(mw >> (32 * sub)) >> (4 * hi);
#pragma unroll
                            for (int r = 0; r < 16; ++r) { if (((mws >> ATT_CR(r)) & 1u) == 0u) S[r] = NEG_BIG; }
                        }
                        float mloc = fmaxf(fmaxf(S[0], S[1]), fmaxf(S[2], S[3]));
#pragma unroll
                        for (int r = 4; r < 16; r += 4) mloc = fmaxf(mloc, fmaxf(fmaxf(S[r], S[r + 1]), fmaxf(S[r + 2], S[r + 3])));
                        const float mnew = fmaxf(m, xhalf_max(mloc));
                        if (__any(mnew > m)) { const float al = __builtin_amdgcn_exp2f(m - mnew); lsum *= al;
#pragma unroll
                            for (int r = 0; r < 16; ++r) { O0[r] *= al; O1[r] *= al; }
                            m = mnew; }
                        float ps = 0.f;
#pragma unroll
                        for (int r = 0; r < 16; ++r) { S[r] = __builtin_amdgcn_exp2f(S[r] - m); ps += S[r]; }
                        lsum += ps;
                        v4u pa, pb;
                        pa.x = cvtpk(S[0], S[1]); pa.y = cvtpk(S[2], S[3]); pa.z = cvtpk(S[4], S[5]); pa.w = cvtpk(S[6], S[7]);
                        pb.x = cvtpk(S[8], S[9]); pb.y = cvtpk(S[10], S[11]); pb.z = cvtpk(S[12], S[13]); pb.w = cvtpk(S[14], S[15]);
                        const bf16x8 P0 = __builtin_bit_cast(bf16x8, pa), P1 = __builtin_bit_cast(bf16x8, pb);
                        const LAS unsigned char* vb = lds + bufo + sub * 4096;
#pragma unroll
                        for (int s = 0; s < 2; ++s) {
                            const s16x4 a0l = vtr(vb + voff[0] + s * 2048), a0h = vtr(vb + voff[0] + s * 2048 + 1024);
                            const s16x4 a1l = vtr(vb + voff[1] + s * 2048), a1h = vtr(vb + voff[1] + s * 2048 + 1024);
                            const bf16x8 A0 = (bf16x8){a0l[0], a0l[1], a0l[2], a0l[3], a0h[0], a0h[1], a0h[2], a0h[3]};
                            const bf16x8 A1 = (bf16x8){a1l[0], a1l[1], a1l[2], a1l[3], a1h[0], a1h[1], a1h[2], a1h[3]};
                            O0 = __builtin_amdgcn_mfma_f32_32x32x16_bf16(A0, s == 0 ? P0 : P1, O0, 0, 0, 0);
                            O1 = __builtin_amdgcn_mfma_f32_32x32x16_bf16(A1, s == 0 ? P0 : P1, O1, 0, 0, 0);
                        }
                    }
                }
                if (c + 1 < nch) { const int bo = ((c + 1) & 1) * BUFB; *(LAS v4u*)(lds + bo + skoff) = kreg; *(LAS v4u*)(lds + bo + svoff) = vreg; mw = mwn; }
                __syncthreads();
            }
        }
        const float rl = 1.0f / xhalf_sum(lsum);
        bf16* op = Oout + qrow * QD + h * HD + 4 * hi;
#pragma unroll
        for (int rq = 0; rq < 4; ++rq) {
            const u64 w0 = (u64)cvtpk(O0[4 * rq] * rl, O0[4 * rq + 1] * rl) | ((u64)cvtpk(O0[4 * rq + 2] * rl, O0[4 * rq + 3] * rl) << 32);
            const u64 w1 = (u64)cvtpk(O1[4 * rq] * rl, O1[4 * rq + 1] * rl) | ((u64)cvtpk(O1[4 * rq + 2] * rl, O1[4 * rq + 3] * rl) << 32);
            *(GAS u64*)(op + 8 * rq) = w0; *(GAS u64*)(op + 32 + 8 * rq) = w1;
        }
    }
}
}

namespace att {
__device__ __forceinline__ void score_phase(const bf16* P, float* SC, LAS unsigned char* lds, int G) {
    int tid = threadIdx.x; OPAQUE_V(tid);
    const int lane = tid & 63, wave = __builtin_amdgcn_readfirstlane(tid >> 6), l31 = lane & 31, hi = lane >> 5;
    int koff[4];
#pragma unroll
    for (int s = 0; s < 4; ++s) koff[s] = l31 * 128 + (((2 * s + hi) ^ ((l31 >> 1) & 7)) << 4);
    const int srow = tid >> 3, spc = tid & 7;
    const int skoff = srow * 128 + ((spc ^ ((srow >> 1) & 7)) << 4);
    for (int it = 0;; ++it) {
        const int v = it * G + (int)blockIdx.x; if (v >= 512) break;
        const int b = v & 1, q = v >> 1, tile = (q < 128) ? q : 383 - q;
        const int t0 = 16 * tile; const size_t brow = (size_t)b * SEQ;
        const int tl = l31 >> 4, hh = l31 & 15;
        const size_t arow = brow + t0 + 2 * wave + tl;
        bf16x8 qa[4];
#pragma unroll
        for (int s = 0; s < 4; ++s) qa[s] = *(const GAS bf16x8*)(P + arow * C_INP + C_QI + hh * IDXD + 16 * s + 8 * hi);
        float wv[2][8];
#pragma unroll
        for (int t2 = 0; t2 < 2; ++t2)
#pragma unroll
            for (int part = 0; part < 2; ++part) { const u64 w4 = *(const GAS u64*)(P + (brow + t0 + 2 * wave + t2) * C_INP + C_WI + 8 * part + 4 * hi);
                wv[t2][4 * part + 0] = bf_lo((unsigned)w4) * 0.03125f; wv[t2][4 * part + 1] = bf_hi((unsigned)w4) * 0.03125f;
                wv[t2][4 * part + 2] = bf_lo((unsigned)(w4 >> 32)) * 0.03125f; wv[t2][4 * part + 3] = bf_hi((unsigned)(w4 >> 32)) * 0.03125f; }
        const int nsub = ((t0 + 15) >> 5) + 1, nch = (nsub + 1) >> 1;
        const bf16* kcol = P + C_KI + spc * 8;
        v4u kreg;
        { int tok = srow; kreg = *(const GAS v4u*)(kcol + (brow + tok) * C_INP); }
        *(LAS v4u*)(lds + skoff) = kreg;
        __syncthreads();
        float* orow = SC + (brow + t0 + 2 * wave + hi) * SEQ + l31;
        for (int c = 0; c < nch; ++c) {
            const int bufo = (c & 1) * BUFB;
            if (c + 1 < nch) { int tok = 64 * (c + 1) + srow; tok = tok > SEQ - 1 ? SEQ - 1 : tok; kreg = *(const GAS v4u*)(kcol + (brow + tok) * C_INP); }
#pragma unroll
            for (int sub = 0; sub < 2; ++sub) {
                if (2 * c + sub < nsub) {
                    f32x16 S;
#pragma unroll
                    for (int r = 0; r < 16; ++r) S[r] = 0.f;
                    const LAS unsigned char* kb = lds + bufo + sub * 4096;
#pragma unroll
                    for (int s = 0; s < 4; ++s) { const bf16x8 kf = *(const LAS bf16x8*)(kb + koff[s]); S = __builtin_amdgcn_mfma_f32_32x32x16_bf16(qa[s], kf, S, 0, 0, 0); }
                    float p0 = 0.f, p1 = 0.f;
#pragma unroll
                    for (int r = 0; r < 8; ++r) { p0 = fmaf(wv[0][r], fmaxf(S[r], 0.f), p0); p1 = fmaf(wv[1][r], fmaxf(S[r + 8], 0.f), p1); }
                    const float x0 = xhalf_sum(p0), x1 = xhalf_sum(p1);
                    orow[64 * c + 32 * sub] = hi ? x1 : x0;
                }
            }
            if (c + 1 < nch) { *(LAS v4u*)(lds + ((c + 1) & 1) * BUFB + skoff) = kreg; }
            __syncthreads();
        }
    }
}
}

#ifndef NEW_ATTN_KINDS
#define NEW_ATTN_KINDS 7
#endif
#ifndef REP_PRO
#define REP_PRO 1
#endif
#ifndef REP_GIN
#define REP_GIN 1
#endif
#ifndef REP_GOUT
#define REP_GOUT 1
#endif
#ifndef REP_GGU
#define REP_GGU 1
#endif
#ifndef REP_GDN
#define REP_GDN 1
#endif
#ifndef REP_LN
#define REP_LN 1
#endif
#ifndef REP_SC
#define REP_SC 1
#endif
#ifndef REP_SEL
#define REP_SEL 1
#endif
#ifndef REP_ATT0
#define REP_ATT0 1
#endif
#ifndef REP_ATT1
#define REP_ATT1 1
#endif
#ifndef REP_ATT2
#define REP_ATT2 1
#endif
#define REPEAT(n) for (int rep_ = 0; rep_ < (n); ++rep_)
constexpr int NPH = 1 + 9 * DEPTH;
__host__ __device__ inline bool phase_exists(int k) { if (k == 0) return true; const int l = (k - 1) / 9, j = (k - 1) % 9; return (j == 1 || j == 2) ? (l % 3 == 2) : true; }

__global__ void __launch_bounds__(NWAVES * 64, 2) fwd_kernel(Params p) {
    extern __shared__ __attribute__((aligned(16))) unsigned char lds_raw[];
    LAS unsigned char* lds = (LAS unsigned char*)lds_raw;
    volatile LAS unsigned* MISC = (volatile LAS unsigned*)(lds + MISC_OFF);
    const int tid = threadIdx.x, lane = tid & 63, wave = __builtin_amdgcn_readfirstlane(tid >> 6);
    const int G = gridDim.x; const int gw = blockIdx.x * NWAVES + wave, NGW = G * NWAVES;
    unsigned char* ws = p.ws;
    gu32* ctl = (gu32*)(ws + WS_CTL);
    for (int u = tid; u < (LDS_BYTES - LDSCTL_OFF) / 4; u += NWAVES * 64) ((LAS unsigned*)(lds + LDSCTL_OFF))[u] = 0u;
    __syncthreads();
    const int lo = p.ph_lo, hi = p.ph_hi;
    XcdBarrier bar; bar.bar = (unsigned*)(ctl + CW_BAR) + p.li * XCD_BAR_WORDS; bar.x = 0; bar.st = nullptr;
    if (hi - lo > 1) bar = xcd_barrier_post((unsigned*)(ctl + CW_BAR) + p.li * XCD_BAR_WORDS, MISC + 8);
#define IN(k) (lo <= (k) && (k) < hi)
#define SEAM(k) do { if ((k) + 1 < hi) xcd_barrier(bar); } while (0)

    bf16* XB = (bf16*)(ws + WS_XB); float* X = (float*)(ws + WS_X); float* Z = (float*)(ws + WS_Z); bf16* O = (bf16*)(ws + WS_O);
    bf16* QKV = (bf16*)(ws + WS_QKV); bf16* H = (bf16*)(ws + WS_H); unsigned char* XB8 = ws + WS_XB8; float* SC = (float*)(ws + WS_SC); u64* MASK = (u64*)(ws + WS_MASK);

    if (IN(0)) REPEAT(REP_PRO) { prologue_phase(p, lds, gw, NGW, wave, lane); SEAM(0); }

    for (int l = 0; l < DEPTH; ++l) {
        const int kind = l % 3, jj = l / 3, pb = 1 + 9 * l;
        const bf16* Win; const bf16* Wout; int Nin;
        if (kind == 0)      { Win = (const bf16*)(ws + WS_W_AIN) + (size_t)jj * A_IN * DM; Wout = (const bf16*)(ws + WS_W_AOUT) + (size_t)jj * DM * QD; Nin = A_IN; }
        else if (kind == 1) { Win = (const bf16*)(ws + WS_W_BIN); Wout = (const bf16*)(ws + WS_W_BOUT); Nin = B_IN; }
        else                { Win = (const bf16*)(ws + WS_W_CIN); Wout = (const bf16*)(ws + WS_W_COUT); Nin = C_INP; }
        const float* xbase = (l == 0) ? p.x : X;

        if (IN(pb + 0)) REPEAT(REP_GIN) {
            pg8::Gemm g{XB, Win, MTOK, Nin, DM}; pg8::StaticOrder S; S.init(MTOK, Nin, G, (int)blockIdx.x);
            pg8::EpiQKV E{QKV, Nin, (kind == 2) ? C_INP : A_IN, QD, C2};
            pg8::gemm_phase<pg8::EpiQKV, pg8::StaticOrder, true, true>(lds, g, S, E);
            SEAM(pb + 0);
        }
        if (kind == 2 && IN(pb + 1)) REPEAT(REP_SC) { att::score_phase(QKV, SC, lds, G); SEAM(pb + 1); }
        if (kind == 2 && IN(pb + 2)) REPEAT(REP_SEL) { select_phase(SC, MASK, gw, NGW, lane); SEAM(pb + 2); }
        if (IN(pb + 3)) REPEAT(kind == 0 ? REP_ATT0 : kind == 1 ? REP_ATT1 : REP_ATT2) {
            att::attn_phase(kind, QKV, Nin, p.a_sinks + jj * NH, MASK, O, lds, G);
            SEAM(pb + 3);
        }
        if (IN(pb + 4)) REPEAT(REP_GOUT) {
            pg8::Gemm g{O, Wout, MTOK, DM, QD}; pg8::StaticOrder S; S.init(MTOK, DM, G, (int)blockIdx.x);
            pg8::EpiResid E{xbase, Z, DM, ALPHA, 1.0f};
            pg8::gemm_phase<pg8::EpiResid, pg8::StaticOrder, true, true>(lds, g, S, E);
            SEAM(pb + 4);
        }
        if (IN(pb + 5)) REPEAT(REP_LN) { ln_phase(Z, p.ln_g + (size_t)(2 * l) * DM, p.ln_b + (size_t)(2 * l) * DM, X, XB, USE_FP8_GU ? XB8 : nullptr, gw, NGW, lane); SEAM(pb + 5); }
        if (IN(pb + 6)) REPEAT(REP_GGU) {
            constexpr float inv = USE_FP8_GU ? 1.0f / (S_X8 * S_WGU8) : 1.0f;
            pg8::StaticOrder S; S.init(MTOK, NGU, G, (int)blockIdx.x);
            pg8::EpiSwiGLU<USE_FP8_DN != 0> E{H, (unsigned char*)H, DFF, inv, S_H8};
#if USE_FP8_GU
            pg8::Gemm g{(const bf16*)XB8, (const bf16*)(ws + WS_W_GU) + (size_t)l * NGU * DM  , MTOK, NGU, DM / 2};
            pg8::gemm_phase<pg8::EpiSwiGLU<USE_FP8_DN != 0>, pg8::StaticOrder, true, true, true>(lds, g, S, E);
#else
            pg8::Gemm g{XB, (const bf16*)(ws + WS_W_GU) + (size_t)l * NGU * DM, MTOK, NGU, DM};
            pg8::gemm_phase<pg8::EpiSwiGLU<USE_FP8_DN != 0>, pg8::StaticOrder, true, true, false>(lds, g, S, E);
#endif
            SEAM(pb + 6);
        }
        if (IN(pb + 7)) REPEAT(REP_GDN) {
            pg8::StaticOrder S; S.init(MTOK, DM, G, (int)blockIdx.x);
#if USE_FP8_DN
            pg8::Gemm g{H, (const bf16*)(ws + WS_W_DN) + (size_t)l * DM * DFF, MTOK, DM, DFF / 2};
            pg8::EpiResid E{X, Z, DM, ALPHA, 1.0f / (S_H8 * S_WDN8)};
            pg8::gemm_phase<pg8::EpiResid, pg8::StaticOrder, true, true, true>(lds, g, S, E);
#else
            pg8::Gemm g{H, (const bf16*)(ws + WS_W_DN) + (size_t)l * DM * DFF, MTOK, DM, DFF};
            pg8::EpiResid E{X, Z, DM, ALPHA, 1.0f};
            pg8::gemm_phase<pg8::EpiResid, pg8::StaticOrder, true, true, false>(lds, g, S, E);
#endif
            SEAM(pb + 7);
        }
        if (IN(pb + 8)) REPEAT(REP_LN) { ln_phase(Z, p.ln_g + (size_t)(2 * l + 1) * DM, p.ln_b + (size_t)(2 * l + 1) * DM, (l == DEPTH - 1) ? p.out : X, XB, nullptr, gw, NGW, lane); SEAM(pb + 8); }
    }
#undef IN
#undef SEAM
}

#ifndef MK_PER_PHASE
#define MK_PER_PHASE 0
#endif
extern "C" void kernel_launch(void* const* d_in, const int* in_sizes, int n_in, void* d_out, int out_size, void* d_ws, size_t ws_size, hipStream_t stream) {
    static int grid = 0;
    if (grid == 0) {
        if (n_in != 12 || in_sizes[0] != MTOK * DM || out_size != MTOK * DM || ws_size < WS_END) {
            fprintf(stderr, "kernel_launch: unexpected shapes (n_in %d, in0 %d, out %d, ws %zu < %zu?); nothing launched\n", n_in, n_in > 0 ? in_sizes[0] : -1, out_size, ws_size, (size_t)WS_END); grid = -1; return; }
        int dev = 0, cus = 0, per_cu = 0;
        if (hipGetDevice(&dev) != hipSuccess || hipDeviceGetAttribute(&cus, hipDeviceAttributeMultiprocessorCount, dev) != hipSuccess) { grid = -1; return; }
        if (hipFuncSetAttribute((const void*)fwd_kernel, hipFuncAttributeMaxDynamicSharedMemorySize, LDS_BYTES) != hipSuccess) { fprintf(stderr, "kernel_launch: hipFuncSetAttribute failed\n"); grid = -1; return; }
        if (hipOccupancyMaxActiveBlocksPerMultiprocessor(&per_cu, (const void*)fwd_kernel, NWAVES * 64, LDS_BYTES) != hipSuccess || per_cu < 1)
            fprintf(stderr, "kernel_launch: note: occupancy query reports %d workgroups per CU\n", per_cu);
        (void)hipGetLastError();
        grid = cus;
    }
    if (grid < 0) return;
    if (hipMemsetAsync((char*)d_ws + WS_CTL, 0, CTL_ZERO_BYTES, stream) != hipSuccess) { fprintf(stderr, "kernel_launch: hipMemsetAsync failed\n"); return; }
    Params a{};
    a.x = (const float*)d_in[0]; a.a_w_in = (const float*)d_in[1]; a.a_sinks = (const float*)d_in[2]; a.a_w_out = (const float*)d_in[3];
    a.b_w_in = (const float*)d_in[4]; a.b_w_out = (const float*)d_in[5]; a.c_w_in = (const float*)d_in[6]; a.c_w_out = (const float*)d_in[7];
    a.ln_g = (const float*)d_in[8]; a.ln_b = (const float*)d_in[9]; a.w_gu = (const float*)d_in[10]; a.w_dn = (const float*)d_in[11];
    a.out = (float*)d_out; a.ws = (unsigned char*)d_ws; a.pad = 0;
#if MK_PER_PHASE
    int li = 0;
    for (int k = 0; k < NPH; ++k) { if (!phase_exists(k)) continue; a.ph_lo = k; a.ph_hi = k + 1; a.li = li++;
        hipLaunchKernelGGL(fwd_kernel, dim3(grid), dim3(NWAVES * 64), LDS_BYTES, stream, a); }
#else
    a.ph_lo = 0; a.ph_hi = NPH; a.li = 0;
    hipLaunchKernelGGL(fwd_kernel, dim3(grid), dim3(NWAVES * 64), LDS_BYTES, stream, a);
#endif
    const hipError_t le = hipPeekAtLastError();
    if (le != hipSuccess) fprintf(stderr, "kernel_launch: launch failed: %s\n", hipGetErrorName(le));
}
```
